# Optimizing an MI355X kernel written in HIP

```python
import math
import jax, jax.numpy as jnp
from jax import lax
import numpy as np

D_MODEL = 1024
BATCH = 4
SEQ = 4096
DEPTH = 2

BLOCK = 128
EPS = 1e-6
HEAD_DIM = 64
SB_HEADS = 8
SW_HEADS = 8
SW_KV_HEADS = 2
SW_GROUP = SW_HEADS // SW_KV_HEADS
WINDOW = 128
SB_WIDTH = SB_HEADS * HEAD_DIM
SW_Q_WIDTH = SW_HEADS * HEAD_DIM
SW_KV_WIDTH = SW_KV_HEADS * HEAD_DIM
EVEN_SPLITS = [SB_WIDTH, SB_WIDTH, SB_WIDTH, SW_Q_WIDTH, SW_KV_WIDTH, SW_KV_WIDTH]
EVEN_IN_WIDTH = sum(EVEN_SPLITS)
EVEN_OUT_WIDTH = SB_WIDTH + SW_Q_WIDTH
REL_BUCKETS = 32
REL_MAX_DIST = 128
MLA_HEADS = 16
MLA_NOPE_DIM = 64
MLA_ROPE_DIM = 32
MLA_V_DIM = 64
MLA_Q_RANK = 384
MLA_KV_RANK = 256
MLA_DOWN_WIDTH = MLA_Q_RANK + MLA_KV_RANK + MLA_ROPE_DIM
ROPE_THETA = 10000.0
FFN_HIDDEN = -(-8 * D_MODEL // (3 * 256)) * 256
N_EVEN = (DEPTH + 1) // 2
N_ODD = DEPTH // 2

kernel_name = "hybrid_stickbreak_swa_mla_block"

F32 = jnp.float32


def rmsnorm(x, g):
    xf = x.astype(F32)
    y = xf * lax.rsqrt(jnp.mean(xf * xf, axis=-1, keepdims=True) + EPS)
    return (y * g.astype(F32)).astype(x.dtype)


def t5_bucket(rel):
    max_exact = REL_BUCKETS // 2
    rel = jnp.maximum(rel, 0)
    relf = jnp.maximum(rel, 1).astype(F32)
    large = max_exact + (jnp.log(relf / max_exact) / math.log(REL_MAX_DIST / max_exact)
                         * (REL_BUCKETS - max_exact)).astype(jnp.int32)
    large = jnp.minimum(large, REL_BUCKETS - 1)
    return jnp.where(rel < max_exact, rel, large)


def stick_breaking_attention(q, k, v):
    B_, S, H, d = q.shape
    nb = S // BLOCK
    scale = d ** -0.5
    qb = q.reshape(B_, nb, BLOCK, H, d).transpose(1, 0, 3, 2, 4)
    key_pos = jnp.arange(S)

    def one_block(args):
        q_blk, i = args
        z = jnp.einsum('bhqd,bshd->bhqs', q_blk, k, preferred_element_type=F32) * scale
        q_pos = i * BLOCK + jnp.arange(BLOCK)
        causal = key_pos[None, :] < q_pos[:, None]
        log_beta = jax.nn.log_sigmoid(z)
        log_1m_beta = jnp.where(causal, jax.nn.log_sigmoid(-z), 0.0)
        between = lax.cumsum(log_1m_beta, axis=3, reverse=True) - log_1m_beta
        w = jnp.where(causal, jnp.exp(log_beta + between), 0.0)
        return jnp.einsum('bhqs,bshd->bqhd', w.astype(v.dtype), v)

    out = lax.map(one_block, (qb, jnp.arange(nb)))
    return out.transpose(1, 0, 2, 3, 4).reshape(B_, S, H * d)


def sliding_window_attention(q, k, v, sinks, rel_bias_table):
    B_, S, Hq, d = q.shape
    Hkv = k.shape[2]
    G = Hq // Hkv
    nb = S // BLOCK
    qb = q.reshape(B_, nb, BLOCK, Hkv, G, d)

    def banded(t):
        tb = t.reshape(B_, nb, BLOCK, Hkv, d)
        prev = jnp.concatenate([jnp.zeros_like(tb[:, :1]), tb[:, :-1]], axis=1)
        return jnp.concatenate([prev, tb], axis=2)

    kb, vb = banded(k), banded(v)
    logits = jnp.einsum('bnqkgd,bnskd->bnkgqs', qb, kb, preferred_element_type=F32) * d ** -0.5
    rel = BLOCK + jnp.arange(BLOCK)[:, None] - jnp.arange(2 * BLOCK)[None, :]
    in_window = (rel >= 0) & (rel < WINDOW)
    key_pos = (jnp.arange(nb)[:, None] - 1) * BLOCK + jnp.arange(2 * BLOCK)[None, :]
    valid = in_window[None] & (key_pos >= 0)[:, None, :]
    bias = rel_bias_table.astype(F32)[t5_bucket(rel)]
    bias = bias.transpose(2, 0, 1).reshape(Hkv, G, BLOCK, 2 * BLOCK)
    logits = jnp.where(valid[None, :, None, None], logits + bias, -jnp.inf)
    sink = sinks.astype(F32).reshape(Hkv, G)[:, :, None, None]
    m = jnp.maximum(jnp.max(logits, axis=-1, keepdims=True), sink)
    p = jnp.exp(logits - m)
    p = p / (jnp.sum(p, axis=-1, keepdims=True) + jnp.exp(sink - m))
    out = jnp.einsum('bnkgqs,bnskd->bnqkgd', p.astype(v.dtype), vb)
    return out.reshape(B_, S, Hq * d)


def rope(x, positions):
    half = x.shape[-1] // 2
    freqs = ROPE_THETA ** (-jnp.arange(half, dtype=F32) / half)
    ang = positions.astype(F32)[..., None] * freqs
    cos = jnp.cos(ang)[:, :, None, :]
    sin = jnp.sin(ang)[:, :, None, :]
    x1 = x[..., :half].astype(F32)
    x2 = x[..., half:].astype(F32)
    return jnp.concatenate([x1 * cos - x2 * sin, x2 * cos + x1 * sin], axis=-1).astype(x.dtype)


def mla_attention(q_nope, q_rope, k_nope, k_rope, v):
    B_, S, H, _ = q_nope.shape
    nb = S // BLOCK
    scale = (MLA_NOPE_DIM + MLA_ROPE_DIM) ** -0.5
    qn = q_nope.reshape(B_, nb, BLOCK, H, MLA_NOPE_DIM).transpose(1, 0, 2, 3, 4)
    qr = q_rope.reshape(B_, nb, BLOCK, H, MLA_ROPE_DIM).transpose(1, 0, 2, 3, 4)
    key_pos = jnp.arange(S)

    def one_block(args):
        qn_blk, qr_blk, i = args
        s = (jnp.einsum('bqhd,bshd->bhqs', qn_blk, k_nope, preferred_element_type=F32)
             + jnp.einsum('bqhr,bsr->bhqs', qr_blk, k_rope, preferred_element_type=F32)) * scale
        q_pos = i * BLOCK + jnp.arange(BLOCK)
        s = jnp.where(key_pos[None, :] <= q_pos[:, None], s, -jnp.inf)
        p = jax.nn.softmax(s, axis=-1)
        return jnp.einsum('bhqs,bshd->bqhd', p.astype(v.dtype), v)

    out = lax.map(one_block, (qn, qr, jnp.arange(nb)))
    return out.transpose(1, 0, 2, 3, 4).reshape(B_, S, H * MLA_V_DIM)


def even_mixer(h, w_in, sinks, rel_bias_table, w_out):
    B_, S, _ = h.shape
    proj = h @ w_in
    q_a, k_a, v_a, q_b, k_b, v_b = jnp.split(proj, list(np.cumsum(EVEN_SPLITS)[:-1]), axis=-1)
    hd = lambda t, n: t.reshape(B_, S, n, HEAD_DIM)
    o_a = stick_breaking_attention(hd(q_a, SB_HEADS), hd(k_a, SB_HEADS), hd(v_a, SB_HEADS))
    o_b = sliding_window_attention(hd(q_b, SW_HEADS), hd(k_b, SW_KV_HEADS), hd(v_b, SW_KV_HEADS),
                                   sinks, rel_bias_table)
    return jnp.concatenate([o_a, o_b], axis=-1) @ w_out


def mla_mixer(h, positions, w_down, q_norm, w_uq, kv_norm, w_ukv, w_o):
    B_, S, _ = h.shape
    down = h @ w_down
    c_q = down[..., :MLA_Q_RANK]
    c_kv = down[..., MLA_Q_RANK:MLA_Q_RANK + MLA_KV_RANK]
    k_rope = down[..., MLA_Q_RANK + MLA_KV_RANK:]
    q = (rmsnorm(c_q, q_norm) @ w_uq).reshape(B_, S, MLA_HEADS, MLA_NOPE_DIM + MLA_ROPE_DIM)
    q_nope = q[..., :MLA_NOPE_DIM]
    q_rope = rope(q[..., MLA_NOPE_DIM:], positions)
    kv = (rmsnorm(c_kv, kv_norm) @ w_ukv).reshape(B_, S, MLA_HEADS, MLA_NOPE_DIM + MLA_V_DIM)
    k_nope = kv[..., :MLA_NOPE_DIM]
    v = kv[..., MLA_NOPE_DIM:]
    k_rope = rope(k_rope[:, :, None, :], positions)[:, :, 0, :]
    return mla_attention(q_nope, q_rope, k_nope, k_rope, v) @ w_o


def swiglu(h, w_gate, w_up, w_down):
    return (jax.nn.silu(h @ w_gate) * (h @ w_up)) @ w_down


def setup_inputs(seed: int = 0) -> dict:
    key = jax.random.key(seed)
    ks = jax.random.split(key, 20)
    nrm = lambda k, shape, fan_in: jax.random.normal(k, shape, F32) * fan_in ** -0.5
    gain = lambda k, shape: 1.0 + 0.02 * jax.random.normal(k, shape, F32)
    x = jax.random.normal(ks[0], (BATCH, SEQ, D_MODEL), F32)
    offsets = jax.random.randint(ks[1], (BATCH, 1), 0, 1024, dtype=jnp.int32)
    positions = (jnp.arange(SEQ, dtype=jnp.int32)[None, :] + offsets).astype(jnp.int32)
    return {
        "x": x,
        "positions": positions,
        "attn_norm": gain(ks[2], (DEPTH, D_MODEL)),
        "ffn_norm": gain(ks[3], (DEPTH, D_MODEL)),
        "even_w_in": nrm(ks[4], (N_EVEN, D_MODEL, EVEN_IN_WIDTH), D_MODEL),
        "even_sinks": 0.5 * jax.random.normal(ks[5], (N_EVEN, SW_HEADS), F32),
        "even_w_out": nrm(ks[6], (N_EVEN, EVEN_OUT_WIDTH, D_MODEL), EVEN_OUT_WIDTH),
        "rel_bias_table": 0.5 * jax.random.normal(ks[7], (REL_BUCKETS, SW_HEADS), F32),
        "mla_w_down": nrm(ks[8], (N_ODD, D_MODEL, MLA_DOWN_WIDTH), D_MODEL),
        "mla_q_norm": gain(ks[9], (N_ODD, MLA_Q_RANK)),
        "mla_w_uq": nrm(ks[10], (N_ODD, MLA_Q_RANK, MLA_HEADS * (MLA_NOPE_DIM + MLA_ROPE_DIM)), MLA_Q_RANK),
        "mla_kv_norm": gain(ks[11], (N_ODD, MLA_KV_RANK)),
        "mla_w_ukv": nrm(ks[12], (N_ODD, MLA_KV_RANK, MLA_HEADS * (MLA_NOPE_DIM + MLA_V_DIM)), MLA_KV_RANK),
        "mla_w_o": nrm(ks[13], (N_ODD, MLA_HEADS * MLA_V_DIM, D_MODEL), MLA_HEADS * MLA_V_DIM),
        "ffn_w_gate": nrm(ks[14], (DEPTH, D_MODEL, FFN_HIDDEN), D_MODEL),
        "ffn_w_up": nrm(ks[15], (DEPTH, D_MODEL, FFN_HIDDEN), D_MODEL),
        "ffn_w_down": nrm(ks[16], (DEPTH, FFN_HIDDEN, D_MODEL), FFN_HIDDEN),
        "final_norm": gain(ks[17], (D_MODEL,)),
    }


def reference(x, positions, attn_norm, ffn_norm, even_w_in, even_sinks, even_w_out, rel_bias_table,
              mla_w_down, mla_q_norm, mla_w_uq, mla_kv_norm, mla_w_ukv, mla_w_o,
              ffn_w_gate, ffn_w_up, ffn_w_down, final_norm):
    for layer in range(DEPTH):
        h = rmsnorm(x, attn_norm[layer])
        if layer % 2 == 0:
            e = layer // 2
            x = x + even_mixer(h, even_w_in[e], even_sinks[e], rel_bias_table, even_w_out[e])
        else:
            o = layer // 2
            x = x + mla_mixer(h, positions, mla_w_down[o], mla_q_norm[o], mla_w_uq[o],
                              mla_kv_norm[o], mla_w_ukv[o], mla_w_o[o])
        h = rmsnorm(x, ffn_norm[layer])
        x = x + swiglu(h, ffn_w_gate[layer], ffn_w_up[layer], ffn_w_down[layer])
    return rmsnorm(x, final_norm)
```

```cpp
#include <hip/hip_runtime.h>
#include <cstdio>
#include <cstdint>

#ifndef MK_ONE_LAUNCH
#define MK_ONE_LAUNCH 1
#endif
#ifndef USE_FAST_GEMM
#define USE_FAST_GEMM 0
#endif

#define GAS __attribute__((address_space(1)))
#define LAS __attribute__((address_space(3)))
typedef unsigned short bf16;
typedef short bf16x8 __attribute__((ext_vector_type(8)));
typedef float f32x4 __attribute__((ext_vector_type(4)));
typedef float f32x2 __attribute__((ext_vector_type(2)));
typedef unsigned u32x4 __attribute__((ext_vector_type(4)));
typedef unsigned u32x2 __attribute__((ext_vector_type(2)));

constexpr int BATCH = 4, SEQ = 4096, DM = 1024, M = BATCH * SEQ;
constexpr int N0 = 2304, FFH = 2816, NGU = 2 * FFH, NMD = 768, QRANK = 384, KVRANK = 256, NUQ = 1536, NUKV = 2048;
constexpr float EPS = 1e-6f;
constexpr float LOG2E = 1.4426950408889634f;
constexpr int NWAVES = 8, NTHR = 512;

constexpr size_t MiB = 1u << 20;
constexpr size_t WS_CTL = 0, CTL_ZERO_BYTES = 1 * MiB;
constexpr size_t WS_W_IN = 1 * MiB;
constexpr size_t WS_W_OUT = WS_W_IN + (size_t)N0 * DM * 2;
constexpr size_t WS_W_GU0 = WS_W_OUT + (size_t)DM * DM * 2;
constexpr size_t WS_W_DN0 = WS_W_GU0 + (size_t)NGU * DM * 2;
constexpr size_t WS_W_MD = WS_W_DN0 + (size_t)DM * FFH * 2;
constexpr size_t WS_W_UQ = WS_W_MD + (size_t)NMD * DM * 2;
constexpr size_t WS_W_UKV = WS_W_UQ + (size_t)NUQ * QRANK * 2;
constexpr size_t WS_W_O = WS_W_UKV + (size_t)NUKV * KVRANK * 2;
constexpr size_t WS_W_GU1 = WS_W_O + (size_t)DM * DM * 2;
constexpr size_t WS_W_DN1 = WS_W_GU1 + (size_t)NGU * DM * 2;
constexpr size_t WS_W_END = WS_W_DN1 + (size_t)DM * FFH * 2;
static_assert(WS_W_END <= 47 * MiB, "weights");
constexpr size_t WS_ST = 47 * MiB;
constexpr size_t WS_SQ = 52 * MiB, WS_SKV = 53 * MiB;
constexpr size_t WS_CS = 54 * MiB;
constexpr size_t WS_XN = 56 * MiB;
constexpr size_t WS_AO = 88 * MiB;
constexpr size_t WS_BIG = 120 * MiB;
constexpr size_t WS_QKV0 = WS_BIG;
constexpr size_t WS_H = WS_BIG;
constexpr size_t WS_CQ = WS_BIG;
constexpr size_t WS_CKV = WS_BIG + 12 * MiB;
constexpr size_t WS_KR = WS_BIG + 20 * MiB;
constexpr size_t WS_QN = WS_BIG + 21 * MiB;
constexpr size_t WS_QR = WS_BIG + 53 * MiB;
constexpr size_t WS_KN = WS_BIG + 69 * MiB;
constexpr size_t WS_VV = WS_BIG + 101 * MiB;
constexpr size_t WS_END = WS_BIG + 133 * MiB;
static_assert(WS_END <= 256 * MiB, "d_ws map");

__device__ __forceinline__ unsigned f2bf(float f) { unsigned u = __builtin_bit_cast(unsigned, f); return (u + 0x7fffu + ((u >> 16) & 1u)) >> 16; }
__device__ __forceinline__ unsigned pk2(float lo, float hi) { return f2bf(lo) | (f2bf(hi) << 16); }
__device__ __forceinline__ float bf2f(unsigned short b) { return __builtin_bit_cast(float, (unsigned)b << 16); }
__device__ __forceinline__ float wave_sum(float v) {
#pragma unroll
    for (int o = 1; o < 64; o <<= 1) v += __shfl_xor(v, o);
    return v;
}

struct Frame {
    int tid, lane, wave, G, bid;
    const float* x; const int* pos; const float* attn_norm; const float* ffn_norm; const float* w_in; const float* sinks; const float* w_out; const float* relb;
    const float* w_md; const float* q_norm; const float* w_uq; const float* kv_norm; const float* w_ukv; const float* w_o; const float* w_gate; const float* w_up; const float* w_down; const float* final_norm;
    float* out; unsigned char* ws;
    bf16 *W_IN, *W_OUT, *W_GU0, *W_DN0, *W_MD, *W_UQ, *W_UKV, *W_O, *W_GU1, *W_DN1;
    float *ST, *SQ, *SKV; f32x2* CS;
    bf16 *XN, *AO, *QKV0, *H, *CQ, *CKV, *KR, *QN, *QR, *KN, *VV;
};

__device__ __forceinline__ float row_rstd(const float* st, int row, int nslots, float inv_dim) {
    const f32x4* p = (const f32x4*)(st + (size_t)row * 16); float s = 0.f;
#pragma unroll
    for (int i = 0; i < 4; ++i) if (4 * i < nslots) { const f32x4 v = p[i]; s += (v.x + v.y) + (v.z + v.w); }
    return 1.0f / sqrtf(s * inv_dim + EPS);
}

enum { R_QKV0 = 0, R_MD = 1, R_UQ = 2, R_UKV = 3 };
struct Route { bf16* dst; int pitch; int col; int rope; int wc0only; float* stat; int slot; };
__device__ __forceinline__ Route route(const Frame& F, int mode, int hh) {
    Route r; r.rope = 0; r.wc0only = 0; r.slot = 0; size_t off, soff = 0; int st = 0;
    if (mode == R_QKV0) { off = WS_QKV0; r.pitch = N0; r.col = hh * 128; }
    else if (mode == R_MD) {
        if (hh < 3) { off = WS_CQ; r.pitch = QRANK; r.col = hh * 128; st = 1; soff = WS_SQ; r.slot = hh * 4; }
        else if (hh == 3) { off = WS_KR; r.pitch = 32; r.col = 0; r.rope = 1; r.wc0only = 1; }
        else { off = WS_CKV; r.pitch = KVRANK; r.col = (hh - 4) * 128; st = 1; soff = WS_SKV; r.slot = (hh - 4) * 4; }
    } else if (mode == R_UQ) {
        if (hh < 8) { off = WS_QN; r.pitch = 1024; r.col = hh * 128; }
        else { off = WS_QR; r.pitch = 512; r.col = (hh - 8) * 128; r.rope = 1; }
    } else {
        if (hh < 8) { off = WS_KN; r.pitch = 1024; r.col = hh * 128; }
        else { off = WS_VV; r.pitch = 1024; r.col = (hh - 8) * 128; }
    }
    r.dst = (bf16*)(F.ws + off); r.stat = st ? (float*)(F.ws + soff) : nullptr;
    return r;
}

enum { WM_IN = 0, WM_PLAIN = 1, WM_GATE = 2, WM_UP = 3, WM_MD = 4, WM_UQ = 5, WM_UKV = 6 };
__device__ __forceinline__ int wmap_row(int mode, int n) {
    switch (mode) {
        case WM_GATE: return (n >> 7) * 256 + (n & 127);
        case WM_UP: return (n >> 7) * 256 + 128 + (n & 127);
        case WM_MD: return n < 384 ? n : (n < 640 ? n + 128 : n - 256);
        case WM_UQ: { const int h = n / 96, e = n % 96; return e < 64 ? h * 64 + e : 1024 + h * 32 + (e - 64); }
        case WM_UKV: { const int h = n >> 7, e = n & 127; return e < 64 ? h * 64 + e : 1024 + h * 64 + (e - 64); }
        default: return n;
    }
}
__device__ __forceinline__ float wmap_scale(int mode, int n) {
    if (mode == WM_IN) return (n < 512 || (n >= 1536 && n < 2048)) ? 0.125f * LOG2E : 1.0f;
    if (mode == WM_UQ) return 0.10206207261596577f * LOG2E;
    return 1.0f;
}
__device__ __forceinline__ void p0_transpose_item(const float* W, const float* gain, int K, int N, bf16* WT, int mode, LAS float* scr, int item, int lane) {
    const int nblk = N / 32, kb = item / nblk, nb = item % nblk, k0 = 64 * kb, n0 = 32 * nb;
#pragma unroll 8
    for (int i = 0; i < 32; ++i) { const int kk = 2 * i + (lane >> 5); const float g = gain ? gain[k0 + kk] : 1.0f; scr[kk * 33 + (lane & 31)] = W[(size_t)(k0 + kk) * N + n0 + (lane & 31)] * g; }
    asm volatile("s_waitcnt lgkmcnt(0)" ::: "memory");
    const int c = lane & 7;
#pragma unroll
    for (int j = 0; j < 4; ++j) { const int n = (lane >> 3) + 8 * j; const LAS float* s = scr + (8 * c) * 33 + n; const float sc = wmap_scale(mode, n0 + n);
        u32x4 o; o.x = pk2(s[0 * 33] * sc, s[1 * 33] * sc); o.y = pk2(s[2 * 33] * sc, s[3 * 33] * sc); o.z = pk2(s[4 * 33] * sc, s[5 * 33] * sc); o.w = pk2(s[6 * 33] * sc, s[7 * 33] * sc);
        *(u32x4*)(WT + (size_t)wmap_row(mode, n0 + n) * K + k0 + 8 * c) = o; }
    asm volatile("s_waitcnt lgkmcnt(0)" ::: "memory");
}
struct WJob { const float* W; const float* gain; int K, N; bf16* WT; int mode; };
__device__ __forceinline__ WJob wjob(const Frame& F, int j) {
    switch (j) {
        case 0: return WJob{F.w_in, F.attn_norm, DM, N0, F.W_IN, WM_IN};
        case 1: return WJob{F.w_out, nullptr, DM, DM, F.W_OUT, WM_PLAIN};
        case 2: return WJob{F.w_gate, F.ffn_norm, DM, FFH, F.W_GU0, WM_GATE};
        case 3: return WJob{F.w_up, F.ffn_norm, DM, FFH, F.W_GU0, WM_UP};
        case 4: return WJob{F.w_down, nullptr, FFH, DM, F.W_DN0, WM_PLAIN};
        case 5: return WJob{F.w_md, F.attn_norm + DM, DM, 672, F.W_MD, WM_MD};
        case 6: return WJob{F.w_uq, F.q_norm, QRANK, NUQ, F.W_UQ, WM_UQ};
        case 7: return WJob{F.w_ukv, F.kv_norm, KVRANK, NUKV, F.W_UKV, WM_UKV};
        case 8: return WJob{F.w_o, nullptr, DM, DM, F.W_O, WM_PLAIN};
        case 9: return WJob{F.w_gate + (size_t)DM * FFH, F.ffn_norm + DM, DM, FFH, F.W_GU1, WM_GATE};
        case 10: return WJob{F.w_up + (size_t)DM * FFH, F.ffn_norm + DM, DM, FFH, F.W_GU1, WM_UP};
        default: return WJob{F.w_down + (size_t)FFH * DM, nullptr, FFH, DM, F.W_DN1, WM_PLAIN};
    }
}
__device__ __forceinline__ void p0_prologue(const Frame& F, LAS unsigned char* lds) {
    LAS float* scr = (LAS float*)(lds + F.wave * 16384);
    const int gw = F.bid * NWAVES + F.wave, NGW = F.G * NWAVES;
    for (int j = 0; j < 12; ++j) { const WJob w = wjob(F, j); const int items = (w.K / 64) * (w.N / 32);
        for (int it = gw; it < items; it += NGW) p0_transpose_item(w.W, w.gain, w.K, w.N, w.WT, w.mode, scr, it, F.lane); }
    for (int i = gw * 64 + F.lane; i < 96 * DM / 8; i += NGW * 64) *(u32x4*)(F.W_MD + (size_t)416 * DM + (size_t)i * 8) = (u32x4){0u, 0u, 0u, 0u};
    for (int m = gw; m < M; m += NGW) {
        const f32x4* xr = (const f32x4*)(F.x + (size_t)m * DM) + F.lane; f32x4 v[4]; float s = 0.f;
#pragma unroll
        for (int j = 0; j < 4; ++j) { v[j] = xr[64 * j]; s += (v[j].x * v[j].x + v[j].y * v[j].y) + (v[j].z * v[j].z + v[j].w * v[j].w); }
        s = wave_sum(s);
        u32x2* o8 = (u32x2*)(F.XN + (size_t)m * DM) + F.lane;
#pragma unroll
        for (int j = 0; j < 4; ++j) o8[64 * j] = (u32x2){pk2(v[j].x, v[j].y), pk2(v[j].z, v[j].w)};
        if (F.lane < 16) F.ST[(size_t)m * 16 + F.lane] = F.lane == 0 ? s : 0.f;
    }
    { f32x4* z = (f32x4*)(F.ST + (size_t)M * 16); const int n4 = 6 * M * 16 / 4;
      for (int i = gw * 64 + F.lane; i < n4; i += NGW * 64) z[i] = (f32x4){0.f, 0.f, 0.f, 0.f}; }
    for (int e = gw * 64 + F.lane; e < M * 16; e += NGW * 64) {
        const int row = e >> 4, i = e & 15;
        const float freq = (float)exp2(-(double)i * (13.287712379549449 / 16.0));
        const float ang = (float)F.pos[row] * freq;
        double rev = (double)ang * 0.15915494309189535; rev -= rint(rev);
        const float rf = (float)rev;
        F.CS[e] = (f32x2){__builtin_amdgcn_cosf(rf), __builtin_amdgcn_sinf(rf)};
    }
}

enum { G_ROWSCALE = 0, G_SWIGLU = 1, G_RESID = 2 };
struct GemmDesc { const bf16* A; const bf16* Bt; int N, K; int kind; int rmode; const float* stat; int nslots; float inv_dim; const float* base; float* xout; bf16* xn; float* stat_out; bf16* hout; };

__device__ __forceinline__ void naive_gemm_phase(const Frame& F, const GemmDesc g) {
    const int lane = F.lane, fr = lane & 15, fq = lane >> 4;
    const int gw = F.bid * NWAVES + F.wave, NGW = F.G * NWAVES;
    const int K = g.K;
    if (g.kind == G_SWIGLU) {
        const int ncb = FFH / 32, units = (M / 32) * ncb;
        for (int u = gw; u < units; u += NGW) {
            const int r0 = (u / ncb) * 32, j0 = (u % ncb) * 32;
            const int brow = (j0 >> 7) * 256 + (j0 & 127);
            f32x4 ag[2][2], au[2][2];
#pragma unroll
            for (int a = 0; a < 2; ++a)
#pragma unroll
                for (int b = 0; b < 2; ++b) { ag[a][b] = (f32x4){0.f, 0.f, 0.f, 0.f}; au[a][b] = (f32x4){0.f, 0.f, 0.f, 0.f}; }
            for (int k0 = 0; k0 < K; k0 += 32) {
                bf16x8 af[2], bg[2], bu[2];
#pragma unroll
                for (int a = 0; a < 2; ++a) af[a] = *(const bf16x8*)(g.A + (size_t)(r0 + 16 * a + fr) * K + k0 + 8 * fq);
#pragma unroll
                for (int b = 0; b < 2; ++b) { bg[b] = *(const bf16x8*)(g.Bt + (size_t)(brow + 16 * b + fr) * K + k0 + 8 * fq); bu[b] = *(const bf16x8*)(g.Bt + (size_t)(brow + 128 + 16 * b + fr) * K + k0 + 8 * fq); }
#pragma unroll
                for (int a = 0; a < 2; ++a)
#pragma unroll
                    for (int b = 0; b < 2; ++b) { ag[a][b] = __builtin_amdgcn_mfma_f32_16x16x32_bf16(af[a], bg[b], ag[a][b], 0, 0, 0); au[a][b] = __builtin_amdgcn_mfma_f32_16x16x32_bf16(af[a], bu[b], au[a][b], 0, 0, 0); }
            }
#pragma unroll
            for (int a = 0; a < 2; ++a)
#pragma unroll
                for (int r = 0; r < 4; ++r) { const int row = r0 + 16 * a + 4 * fq + r; const float rs = row_rstd(g.stat, row, g.nslots, g.inv_dim);
#pragma unroll
                    for (int b = 0; b < 2; ++b) { const float gv = ag[a][b][r] * rs, uv = au[a][b][r] * rs; const float hv = gv * uv / (1.0f + __builtin_amdgcn_exp2f(-gv * LOG2E));
                        g.hout[(size_t)row * FFH + j0 + 16 * b + fr] = (bf16)f2bf(hv); } }
        }
        return;
    }
    const int ncb = g.N / 64, units = (M / 32) * ncb;
    for (int u = gw; u < units; u += NGW) {
        const int r0 = (u / ncb) * 32, c0 = (u % ncb) * 64;
        f32x4 acc[2][4];
#pragma unroll
        for (int a = 0; a < 2; ++a)
#pragma unroll
            for (int b = 0; b < 4; ++b) acc[a][b] = (f32x4){0.f, 0.f, 0.f, 0.f};
        for (int k0 = 0; k0 < K; k0 += 32) {
            bf16x8 af[2], bfr[4];
#pragma unroll
            for (int a = 0; a < 2; ++a) af[a] = *(const bf16x8*)(g.A + (size_t)(r0 + 16 * a + fr) * K + k0 + 8 * fq);
#pragma unroll
            for (int b = 0; b < 4; ++b) bfr[b] = *(const bf16x8*)(g.Bt + (size_t)(c0 + 16 * b + fr) * K + k0 + 8 * fq);
#pragma unroll
            for (int a = 0; a < 2; ++a)
#pragma unroll
                for (int b = 0; b < 4; ++b) acc[a][b] = __builtin_amdgcn_mfma_f32_16x16x32_bf16(af[a], bfr[b], acc[a][b], 0, 0, 0);
        }
        if (g.kind == G_RESID) {
#pragma unroll
            for (int a = 0; a < 2; ++a)
#pragma unroll
                for (int r = 0; r < 4; ++r) { const int row = r0 + 16 * a + 4 * fq + r; float ss = 0.f;
#pragma unroll
                    for (int b = 0; b < 4; ++b) { const int col = c0 + 16 * b + fr; const size_t o = (size_t)row * DM + col; const float v = g.base[o] + acc[a][b][r]; g.xout[o] = v; if (g.xn) g.xn[o] = (bf16)f2bf(v); ss += v * v; }
                    ss += __shfl_xor(ss, 1); ss += __shfl_xor(ss, 2); ss += __shfl_xor(ss, 4); ss += __shfl_xor(ss, 8);
                    if (fr == 0) atomicAdd(g.stat_out + (size_t)row * 16, ss); }
        } else {
            const int hh = c0 >> 7; const Route rt = route(F, g.rmode, hh); const int cin = c0 & 127;
            if (rt.wc0only && cin != 0) continue;
#pragma unroll
            for (int a = 0; a < 2; ++a)
#pragma unroll
                for (int r = 0; r < 4; ++r) { const int row = r0 + 16 * a + 4 * fq + r; const float rs = row_rstd(g.stat, row, g.nslots, g.inv_dim);
                    float v[4]; float ss = 0.f;
#pragma unroll
                    for (int b = 0; b < 4; ++b) { v[b] = acc[a][b][r] * rs; ss += v[b] * v[b]; }
                    if (rt.rope) { const f32x2 cs = F.CS[(size_t)row * 16 + fr];
#pragma unroll
                        for (int p = 0; p < 2; ++p) { const float x1 = v[2 * p], x2 = v[2 * p + 1]; v[2 * p] = x1 * cs.x - x2 * cs.y; v[2 * p + 1] = x2 * cs.x + x1 * cs.y; } }
#pragma unroll
                    for (int b = 0; b < 4; ++b) { if (rt.wc0only && b >= 2) break; rt.dst[(size_t)row * rt.pitch + rt.col + cin + 16 * b + fr] = (bf16)f2bf(v[b]); }
                    if (rt.stat) { ss += __shfl_xor(ss, 1); ss += __shfl_xor(ss, 2); ss += __shfl_xor(ss, 4); ss += __shfl_xor(ss, 8); if (fr == 0) atomicAdd(rt.stat + (size_t)row * 16, ss); } }
        }
    }
}

__device__ __forceinline__ float dot8(const float* q, const u32x4 c) {
    return q[0] * __builtin_bit_cast(float, c.x << 16) + q[1] * __builtin_bit_cast(float, c.x & 0xffff0000u) + q[2] * __builtin_bit_cast(float, c.y << 16) + q[3] * __builtin_bit_cast(float, c.y & 0xffff0000u)
         + q[4] * __builtin_bit_cast(float, c.z << 16) + q[5] * __builtin_bit_cast(float, c.z & 0xffff0000u) + q[6] * __builtin_bit_cast(float, c.w << 16) + q[7] * __builtin_bit_cast(float, c.w & 0xffff0000u);
}
__device__ __forceinline__ void axpy8(float* o, float al, float p, const u32x4 c) {
    o[0] = o[0] * al + p * __builtin_bit_cast(float, c.x << 16); o[1] = o[1] * al + p * __builtin_bit_cast(float, c.x & 0xffff0000u);
    o[2] = o[2] * al + p * __builtin_bit_cast(float, c.y << 16); o[3] = o[3] * al + p * __builtin_bit_cast(float, c.y & 0xffff0000u);
    o[4] = o[4] * al + p * __builtin_bit_cast(float, c.z << 16); o[5] = o[5] * al + p * __builtin_bit_cast(float, c.z & 0xffff0000u);
    o[6] = o[6] * al + p * __builtin_bit_cast(float, c.w << 16); o[7] = o[7] * al + p * __builtin_bit_cast(float, c.w & 0xffff0000u);
}
__device__ __forceinline__ void naive_sb(const Frame& F) {
    const int gw = F.bid * NWAVES + F.wave, NGW = F.G * NWAVES;
    for (int u = gw; u < BATCH * 8 * (SEQ / 64); u += NGW) {
        const int blk = u % (SEQ / 64), h = (u / (SEQ / 64)) % 8, b = u / (SEQ / 64 * 8);
        const int t = blk * 64 + F.lane; const size_t rowq = (size_t)b * SEQ + t;
        float q[64], o[64];
#pragma unroll
        for (int d = 0; d < 64; ++d) { q[d] = bf2f(F.QKV0[rowq * N0 + h * 64 + d]); o[d] = 0.f; }
        float carry = 0.f;
        for (int s = blk * 64 + 63; s >= 0; --s) {
            const bf16* kr = F.QKV0 + ((size_t)b * SEQ + s) * N0 + 512 + h * 64; const bf16* vr = kr + 512;
            float y = 0.f;
#pragma unroll
            for (int d = 0; d < 8; ++d) y += dot8(q + 8 * d, ((const u32x4*)kr)[d]);
            const bool valid = s < t;
            const float sp = fmaxf(y, 0.f) + __builtin_amdgcn_logf(1.0f + __builtin_amdgcn_exp2f(-fabsf(y)));
            const float w = valid ? __builtin_amdgcn_exp2f((y - sp) + carry) : 0.f;
            if (valid) carry -= sp;
#pragma unroll
            for (int d = 0; d < 8; ++d) axpy8(o + 8 * d, 1.0f, w, ((const u32x4*)vr)[d]);
        }
#pragma unroll
        for (int d = 0; d < 64; ++d) F.AO[rowq * DM + h * 64 + d] = (bf16)f2bf(o[d]);
    }
}
__device__ __forceinline__ float t5_bias2(const Frame& F, int rel, int h) {
    int bk = rel;
    if (rel >= 16) { bk = 16 + (int)(log2f((float)rel * 0.0625f) * (16.0f / 3.0f)); bk = bk > 31 ? 31 : bk; }
    return F.relb[bk * 8 + h] * LOG2E;
}
__device__ __forceinline__ void naive_swa(const Frame& F) {
    const int gw = F.bid * NWAVES + F.wave, NGW = F.G * NWAVES;
    for (int u = gw; u < BATCH * 8 * (SEQ / 64); u += NGW) {
        const int blk = u % (SEQ / 64), h = (u / (SEQ / 64)) % 8, b = u / (SEQ / 64 * 8), kvh = h >> 2;
        const int t = blk * 64 + F.lane; const size_t rowq = (size_t)b * SEQ + t;
        float q[64], o[64];
#pragma unroll
        for (int d = 0; d < 64; ++d) { q[d] = bf2f(F.QKV0[rowq * N0 + 1536 + h * 64 + d]); o[d] = 0.f; }
        float m = F.sinks[h] * LOG2E, l = 1.0f;
        const int s_lo = blk * 64 - 127 < 0 ? 0 : blk * 64 - 127;
        for (int s = s_lo; s <= blk * 64 + 63; ++s) {
            const bf16* kr = F.QKV0 + ((size_t)b * SEQ + s) * N0 + 2048 + kvh * 64; const bf16* vr = kr + 128;
            float y = 0.f;
#pragma unroll
            for (int d = 0; d < 8; ++d) y += dot8(q + 8 * d, ((const u32x4*)kr)[d]);
            const int rel = t - s; const bool valid = rel >= 0 && rel < 128;
            const float lg = valid ? y + t5_bias2(F, rel & 127, h) : -INFINITY;
            const float mn = fmaxf(m, lg), al = __builtin_amdgcn_exp2f(m - mn), p = __builtin_amdgcn_exp2f(lg - mn);
            l = l * al + p; m = mn;
#pragma unroll
            for (int d = 0; d < 8; ++d) axpy8(o + 8 * d, al, p, ((const u32x4*)vr)[d]);
        }
        const float il = 1.0f / l;
#pragma unroll
        for (int d = 0; d < 64; ++d) F.AO[rowq * DM + 512 + h * 64 + d] = (bf16)f2bf(o[d] * il);
    }
}
__device__ __forceinline__ void naive_mla(const Frame& F) {
    const int gw = F.bid * NWAVES + F.wave, NGW = F.G * NWAVES;
    for (int u = gw; u < BATCH * 16 * (SEQ / 64); u += NGW) {
        const int blk = (SEQ / 64 - 1) - u % (SEQ / 64), h = (u / (SEQ / 64)) % 16, b = u / (SEQ / 64 * 16);
        const int t = blk * 64 + F.lane; const size_t rowq = (size_t)b * SEQ + t;
        float q[96], o[64];
#pragma unroll
        for (int d = 0; d < 64; ++d) { q[d] = bf2f(F.QN[rowq * 1024 + h * 64 + d]); o[d] = 0.f; }
#pragma unroll
        for (int d = 0; d < 32; ++d) q[64 + d] = bf2f(F.QR[rowq * 512 + h * 32 + d]);
        float m = -1e30f, l = 0.f;
        for (int s = 0; s <= blk * 64 + 63; ++s) {
            const size_t rk = (size_t)b * SEQ + s; const bf16* kn = F.KN + rk * 1024 + h * 64; const bf16* kr = F.KR + rk * 32; const bf16* vr = F.VV + rk * 1024 + h * 64;
            float y = 0.f;
#pragma unroll
            for (int d = 0; d < 8; ++d) y += dot8(q + 8 * d, ((const u32x4*)kn)[d]);
#pragma unroll
            for (int d = 0; d < 4; ++d) y += dot8(q + 64 + 8 * d, ((const u32x4*)kr)[d]);
            const float lg = s <= t ? y : -INFINITY;
            const float mn = fmaxf(m, lg), al = __builtin_amdgcn_exp2f(m - mn), p = __builtin_amdgcn_exp2f(lg - mn);
            l = l * al + p; m = mn;
#pragma unroll
            for (int d = 0; d < 8; ++d) axpy8(o + 8 * d, al, p, ((const u32x4*)vr)[d]);
        }
        const float il = 1.0f / l;
#pragma unroll
        for (int d = 0; d < 64; ++d) F.AO[rowq * DM + h * 64 + d] = (bf16)f2bf(o[d] * il);
    }
}
__device__ __forceinline__ void final_norm_phase(const Frame& F) {
    const int gw = F.bid * NWAVES + F.wave, NGW = F.G * NWAVES;
    for (int m = gw; m < M; m += NGW) {
        const float rs = row_rstd(F.ST + (size_t)4 * M * 16, m, 16, 1.0f / DM);
        f32x4* xr = (f32x4*)(F.out + (size_t)m * DM) + F.lane; const f32x4* gr = (const f32x4*)F.final_norm + F.lane;
#pragma unroll
        for (int j = 0; j < 4; ++j) { const f32x4 v = xr[64 * j], g = gr[64 * j]; xr[64 * j] = v * rs * g; }
    }
}

#define RLX_AGENT __ATOMIC_RELAXED, __HIP_MEMORY_SCOPE_AGENT
#define XB_TMO      128
#define XB_XCNT(j)  (256  + 64 * (j))
#define XB_XSUB(j)  (1280 + 64 * (j))
#define XB_XGEN(j)  (2304 + 64 * (j))
#define XB_TOP      3328
#define XB_TOPGEN   3392
#define XCD_BAR_WORDS 3456
#define XB_SPIN_CAP (1u << 22)
__device__ __forceinline__ unsigned xb_ld(unsigned* p)              { return __hip_atomic_load(p, __ATOMIC_RELAXED, __HIP_MEMORY_SCOPE_AGENT); }
__device__ __forceinline__ unsigned xb_add(unsigned* p, unsigned v) { return __hip_atomic_fetch_add(p, v, __ATOMIC_RELAXED, __HIP_MEMORY_SCOPE_AGENT); }
__device__ __forceinline__ unsigned xb_xcc_id() { return (unsigned)__builtin_amdgcn_s_getreg((3 << 11) | 20) & 0xFu; }
#define XB_SPIN(cond, bar) do { unsigned _sp = 0; while (cond) { __builtin_amdgcn_s_sleep(1); \
    if ((++_sp & 255u) == 0u) { if (xb_ld(&(bar)[XB_TMO])) break; if (_sp > XB_SPIN_CAP) { atomicAdd(&(bar)[XB_TMO], 1u); break; } } } } while (0)
struct XcdBarrier { unsigned* bar; unsigned x; volatile LAS unsigned* st; };
__device__ __forceinline__ XcdBarrier xcd_barrier_post(unsigned* bar, volatile LAS unsigned* st) {
    XcdBarrier b; b.bar = bar; b.x = xb_xcc_id(); b.st = st;
    if (threadIdx.x == 0) (void)xb_add(&bar[XB_XCNT(b.x)], 1u);
    return b;
}
__device__ __forceinline__ void xcd_barrier_complete(unsigned* bar, unsigned x, unsigned& nloc, unsigned& nx) {
    const unsigned G = gridDim.x * gridDim.y * gridDim.z;
    unsigned sum, cnt, mine, sp = 0u;
    for (;;) {
        sum = 0u; cnt = 0u; mine = 0u;
#pragma unroll
        for (unsigned j = 0; j < 16; ++j) { const unsigned c = xb_ld(&bar[XB_XCNT(j)]); sum += c; cnt += (c > 0u) ? 1u : 0u; mine = (j == x) ? c : mine; }
        if (sum == G) break;
        __builtin_amdgcn_s_sleep(1);
        if ((++sp & 255u) == 0u) { if (xb_ld(&bar[XB_TMO])) break; if (sp > XB_SPIN_CAP) { atomicAdd(&bar[XB_TMO], 1u); break; } }
    }
    nloc = mine > 0u ? mine : 1u; nx = cnt > 0u ? cnt : 1u;
}
__device__ __forceinline__ void xcd_barrier(const XcdBarrier& b) {
    asm volatile("s_waitcnt vmcnt(0)" ::: "memory");
    __syncthreads();
    if (threadIdx.x == 0) {
        unsigned* bar = b.bar;
        __builtin_amdgcn_s_waitcnt(0);
        unsigned nloc = b.st[0], nx = b.st[1];
        if (nloc == 0u) { xcd_barrier_complete(bar, b.x, nloc, nx); b.st[0] = nloc; b.st[1] = nx; }
        const unsigned old = xb_add(&bar[XB_XSUB(b.x)], 1u);
        const unsigned gen = old / nloc;
        if (old + 1u == (gen + 1u) * nloc) {
            __builtin_amdgcn_fence(__ATOMIC_RELEASE, "agent");
            asm volatile("s_waitcnt vmcnt(0)" ::: "memory");
            const unsigned og = xb_add(&bar[XB_TOP], 1u);
            const unsigned tg = og / nx;
            if (og + 1u == (tg + 1u) * nx) xb_add(&bar[XB_TOPGEN], 1u);
            else XB_SPIN(xb_ld(&bar[XB_TOPGEN]) == tg, bar);
            __builtin_amdgcn_fence(__ATOMIC_ACQUIRE, "agent");
            xb_add(&bar[XB_XGEN(b.x)], 1u);
            asm volatile("s_waitcnt vmcnt(0)" ::: "memory");
        } else {
            XB_SPIN(xb_ld(&bar[XB_XGEN(b.x)]) == gen, bar);
            __builtin_amdgcn_fence(__ATOMIC_ACQUIRE, "agent");
            asm volatile("s_waitcnt vmcnt(0)" ::: "memory");
        }
    }
    __syncthreads();
}
constexpr int RING_BYTES = 131072, LDSCTL_OFF = RING_BYTES, MISC_OFF = LDSCTL_OFF + 320;
constexpr int LDS_BYTES = 147456;
constexpr int CW_BAR = 4096;

constexpr int N_PHASES = 14;
__device__ __forceinline__ GemmDesc gemm_desc(const Frame& F, int ph) {
    GemmDesc g; float* ST = F.ST; const size_t S1 = (size_t)M * 16;
    g.A = F.XN; g.Bt = F.W_IN; g.N = DM; g.K = DM; g.kind = G_RESID; g.rmode = 0; g.stat = ST; g.nslots = 16; g.inv_dim = 1.0f / DM;
    g.base = F.out; g.xout = F.out; g.xn = F.XN; g.stat_out = ST; g.hout = F.H;
    if (ph == 1) { g.Bt = F.W_IN; g.N = N0; g.kind = G_ROWSCALE; g.rmode = R_QKV0; }
    else if (ph == 3) { g.A = F.AO; g.Bt = F.W_OUT; g.base = F.x; g.stat_out = ST + S1; }
    else if (ph == 4) { g.Bt = F.W_GU0; g.N = NGU; g.kind = G_SWIGLU; g.stat = ST + S1; }
    else if (ph == 5) { g.A = F.H; g.Bt = F.W_DN0; g.K = FFH; g.stat_out = ST + 2 * S1; }
    else if (ph == 6) { g.Bt = F.W_MD; g.N = NMD; g.kind = G_ROWSCALE; g.rmode = R_MD; g.stat = ST + 2 * S1; }
    else if (ph == 7) { g.A = F.CQ; g.Bt = F.W_UQ; g.N = NUQ; g.K = QRANK; g.kind = G_ROWSCALE; g.rmode = R_UQ; g.stat = F.SQ; g.nslots = 12; g.inv_dim = 1.0f / QRANK; }
    else if (ph == 8) { g.A = F.CKV; g.Bt = F.W_UKV; g.N = NUKV; g.K = KVRANK; g.kind = G_ROWSCALE; g.rmode = R_UKV; g.stat = F.SKV; g.nslots = 8; g.inv_dim = 1.0f / KVRANK; }
    else if (ph == 10) { g.A = F.AO; g.Bt = F.W_O; g.stat_out = ST + 3 * S1; }
    else if (ph == 11) { g.Bt = F.W_GU1; g.N = NGU; g.kind = G_SWIGLU; g.stat = ST + 3 * S1; }
    else { g.A = F.H; g.Bt = F.W_DN1; g.K = FFH; g.xn = nullptr; g.stat_out = ST + 4 * S1; }
    return g;
}

struct Args { const void* in[18]; float* out; unsigned char* ws; int ph_lo, ph_hi; };
__global__ void __launch_bounds__(NTHR, 2) mk_fwd(Args a) {
    extern __shared__ __attribute__((aligned(16))) unsigned char lds_raw[];
    LAS unsigned char* lds = (LAS unsigned char*)lds_raw;
    Frame F;
    F.tid = threadIdx.x; F.lane = F.tid & 63; F.wave = __builtin_amdgcn_readfirstlane(F.tid >> 6); F.G = gridDim.x; F.bid = blockIdx.x;
    F.x = (const float*)a.in[0]; F.pos = (const int*)a.in[1]; F.attn_norm = (const float*)a.in[2]; F.ffn_norm = (const float*)a.in[3]; F.w_in = (const float*)a.in[4]; F.sinks = (const float*)a.in[5];
    F.w_out = (const float*)a.in[6]; F.relb = (const float*)a.in[7]; F.w_md = (const float*)a.in[8]; F.q_norm = (const float*)a.in[9]; F.w_uq = (const float*)a.in[10]; F.kv_norm = (const float*)a.in[11];
    F.w_ukv = (const float*)a.in[12]; F.w_o = (const float*)a.in[13]; F.w_gate = (const float*)a.in[14]; F.w_up = (const float*)a.in[15]; F.w_down = (const float*)a.in[16]; F.final_norm = (const float*)a.in[17];
    F.out = a.out; F.ws = a.ws; unsigned char* ws = a.ws;
    F.W_IN = (bf16*)(ws + WS_W_IN); F.W_OUT = (bf16*)(ws + WS_W_OUT); F.W_GU0 = (bf16*)(ws + WS_W_GU0); F.W_DN0 = (bf16*)(ws + WS_W_DN0); F.W_MD = (bf16*)(ws + WS_W_MD);
    F.W_UQ = (bf16*)(ws + WS_W_UQ); F.W_UKV = (bf16*)(ws + WS_W_UKV); F.W_O = (bf16*)(ws + WS_W_O); F.W_GU1 = (bf16*)(ws + WS_W_GU1); F.W_DN1 = (bf16*)(ws + WS_W_DN1);
    F.ST = (float*)(ws + WS_ST); F.SQ = (float*)(ws + WS_SQ); F.SKV = (float*)(ws + WS_SKV); F.CS = (f32x2*)(ws + WS_CS);
    F.XN = (bf16*)(ws + WS_XN); F.AO = (bf16*)(ws + WS_AO); F.QKV0 = (bf16*)(ws + WS_QKV0); F.H = (bf16*)(ws + WS_H); F.CQ = (bf16*)(ws + WS_CQ); F.CKV = (bf16*)(ws + WS_CKV);
    F.KR = (bf16*)(ws + WS_KR); F.QN = (bf16*)(ws + WS_QN); F.QR = (bf16*)(ws + WS_QR); F.KN = (bf16*)(ws + WS_KN); F.VV = (bf16*)(ws + WS_VV);

    for (int u = F.tid; u < (LDS_BYTES - LDSCTL_OFF) / 4; u += NTHR) ((LAS unsigned*)(lds + LDSCTL_OFF))[u] = 0u;
    __syncthreads();
    XcdBarrier bar; bar.bar = (unsigned*)(ws + WS_CTL) + CW_BAR; bar.x = 0; bar.st = nullptr;
    if (a.ph_hi - a.ph_lo > 1) bar = xcd_barrier_post((unsigned*)(ws + WS_CTL) + CW_BAR, (volatile LAS unsigned*)(lds + MISC_OFF) + 8);
    for (int ph = a.ph_lo; ph < a.ph_hi; ++ph) {
        if (ph == 0) p0_prologue(F, lds);
        else if (ph == 2) { naive_sb(F); naive_swa(F); }
        else if (ph == 9) naive_mla(F);
        else if (ph == 13) final_norm_phase(F);
        else naive_gemm_phase(F, gemm_desc(F, ph));
        if (ph + 1 < a.ph_hi && ph != 7) xcd_barrier(bar);
    }
}

extern "C" void kernel_launch(void* const* d_in, const int* in_sizes, int n_in, void* d_out, int out_size, void* d_ws, size_t ws_size, hipStream_t stream) {
    static int grid = 0;
    if (grid == 0) {
        if (n_in != 18 || in_sizes[0] != M * DM || out_size != M * DM || ws_size < WS_END) { fprintf(stderr, "kernel_launch: unexpected problem shape / workspace (n_in %d, ws %zu)\n", n_in, ws_size); grid = -1; return; }
        int dev = 0, cus = 0;
        if (hipGetDevice(&dev) != hipSuccess || hipDeviceGetAttribute(&cus, hipDeviceAttributeMultiprocessorCount, dev) != hipSuccess) { grid = -1; return; }
        if (hipFuncSetAttribute((const void*)mk_fwd, hipFuncAttributeMaxDynamicSharedMemorySize, LDS_BYTES) != hipSuccess) { fprintf(stderr, "kernel_launch: hipFuncSetAttribute failed\n"); grid = -1; return; }
        grid = cus;
    }
    if (grid < 0) return;
    Args a{};
    for (int i = 0; i < 18; ++i) a.in[i] = d_in[i];
    a.out = (float*)d_out; a.ws = (unsigned char*)d_ws;
#if MK_ONE_LAUNCH
    if (hipMemsetAsync((char*)d_ws + WS_CTL, 0, 65536, stream) != hipSuccess) { fprintf(stderr, "kernel_launch: memset failed\n"); return; }
    a.ph_lo = 0; a.ph_hi = N_PHASES;
    void* kargs[] = {&a};
    const hipError_t e = hipLaunchCooperativeKernel((const void*)mk_fwd, dim3(grid), dim3(NTHR), kargs, LDS_BYTES, stream);
    if (e != hipSuccess) fprintf(stderr, "kernel_launch: cooperative launch failed: %s (grid %d)\n", hipGetErrorString(e), grid);
#else
    for (int ph = 0; ph < N_PHASES; ++ph) {
        a.ph_lo = ph; a.ph_hi = ph + 1;
        hipLaunchKernelGGL(mk_fwd, dim3(grid), dim3(NTHR), LDS_BYTES, stream, a);
    }
#endif
}
```

```cpp
#include <hip/hip_runtime.h>
#include <cstdio>
#include <cstdint>

#ifndef MK_ONE_LAUNCH
#define MK_ONE_LAUNCH 1
#endif
#ifndef USE_FAST_GEMM
#define USE_FAST_GEMM 1
#endif
#ifndef USE_FAST_SB
#define USE_FAST_SB 1
#endif
#ifndef USE_FAST_SWA
#define USE_FAST_SWA 1
#endif
#ifndef USE_FAST_MLA
#define USE_FAST_MLA 1
#endif

#define GAS __attribute__((address_space(1)))
#define LAS __attribute__((address_space(3)))
typedef unsigned short bf16;
typedef short bf16x8 __attribute__((ext_vector_type(8)));
typedef float f32x4 __attribute__((ext_vector_type(4)));
typedef float f32x2 __attribute__((ext_vector_type(2)));
typedef unsigned u32x4 __attribute__((ext_vector_type(4)));
typedef unsigned u32x2 __attribute__((ext_vector_type(2)));

constexpr int BATCH = 4, SEQ = 4096, DM = 1024, M = BATCH * SEQ;
constexpr int N0 = 2304, FFH = 2816, NGU = 2 * FFH, NMD = 768, QRANK = 384, KVRANK = 256, NUQ = 1536, NUKV = 2048;
constexpr float EPS = 1e-6f;
constexpr float LOG2E = 1.4426950408889634f;
constexpr int NWAVES = 8, NTHR = 512;

constexpr size_t MiB = 1u << 20;
constexpr size_t WS_CTL = 0, CTL_ZERO_BYTES = 1 * MiB;
constexpr size_t WS_W_IN = 1 * MiB;
constexpr size_t WS_W_OUT = WS_W_IN + (size_t)N0 * DM * 2;
constexpr size_t WS_W_GU0 = WS_W_OUT + (size_t)DM * DM * 2;
constexpr size_t WS_W_DN0 = WS_W_GU0 + (size_t)NGU * DM * 2;
constexpr size_t WS_W_MD = WS_W_DN0 + (size_t)DM * FFH * 2;
constexpr size_t WS_W_UQ = WS_W_MD + (size_t)NMD * DM * 2;
constexpr size_t WS_W_UKV = WS_W_UQ + (size_t)NUQ * QRANK * 2;
constexpr size_t WS_W_O = WS_W_UKV + (size_t)NUKV * KVRANK * 2;
constexpr size_t WS_W_GU1 = WS_W_O + (size_t)DM * DM * 2;
constexpr size_t WS_W_DN1 = WS_W_GU1 + (size_t)NGU * DM * 2;
constexpr size_t WS_W_END = WS_W_DN1 + (size_t)DM * FFH * 2;
static_assert(WS_W_END <= 47 * MiB, "weights");
constexpr size_t WS_ST = 47 * MiB;
constexpr size_t WS_SQ = 52 * MiB, WS_SKV = 53 * MiB;
constexpr size_t WS_CS = 54 * MiB;
constexpr size_t WS_XN = 56 * MiB;
constexpr size_t WS_AO = 88 * MiB;
constexpr size_t WS_BIG = 120 * MiB;
constexpr size_t WS_QKV0 = WS_BIG;
constexpr size_t WS_H = WS_BIG;
constexpr size_t WS_CQ = WS_BIG;
constexpr size_t WS_CKV = WS_BIG + 12 * MiB;
constexpr size_t WS_KR = WS_BIG + 20 * MiB;
constexpr size_t WS_QN = WS_BIG + 21 * MiB;
constexpr size_t WS_QR = WS_BIG + 53 * MiB;
constexpr size_t WS_KN = WS_BIG + 69 * MiB;
constexpr size_t WS_VV = WS_BIG + 101 * MiB;
constexpr size_t WS_END = WS_BIG + 133 * MiB;
static_assert(WS_END <= 256 * MiB, "d_ws map");

__device__ __forceinline__ unsigned f2bf(float f) { unsigned u = __builtin_bit_cast(unsigned, f); return (u + 0x7fffu + ((u >> 16) & 1u)) >> 16; }
__device__ __forceinline__ unsigned pk2(float lo, float hi) { return f2bf(lo) | (f2bf(hi) << 16); }
__device__ __forceinline__ float bf2f(unsigned short b) { return __builtin_bit_cast(float, (unsigned)b << 16); }
__device__ __forceinline__ float wave_sum(float v) {
#pragma unroll
    for (int o = 1; o < 64; o <<= 1) v += __shfl_xor(v, o);
    return v;
}

struct Frame {
    int tid, lane, wave, G, bid;
    const float* x; const int* pos; const float* attn_norm; const float* ffn_norm; const float* w_in; const float* sinks; const float* w_out; const float* relb;
    const float* w_md; const float* q_norm; const float* w_uq; const float* kv_norm; const float* w_ukv; const float* w_o; const float* w_gate; const float* w_up; const float* w_down; const float* final_norm;
    float* out; unsigned char* ws;
    bf16 *W_IN, *W_OUT, *W_GU0, *W_DN0, *W_MD, *W_UQ, *W_UKV, *W_O, *W_GU1, *W_DN1;
    float *ST, *SQ, *SKV; f32x2* CS;
    bf16 *XN, *AO, *QKV0, *H, *CQ, *CKV, *KR, *QN, *QR, *KN, *VV;
};

__device__ __forceinline__ float row_rstd(const float* st, int row, int nslots, float inv_dim) {
    const f32x4* p = (const f32x4*)(st + (size_t)row * 16); float s = 0.f;
#pragma unroll
    for (int i = 0; i < 4; ++i) if (4 * i < nslots) { const f32x4 v = p[i]; s += (v.x + v.y) + (v.z + v.w); }
    return 1.0f / sqrtf(s * inv_dim + EPS);
}

enum { R_QKV0 = 0, R_MD = 1, R_UQ = 2, R_UKV = 3 };
struct Route { bf16* dst; int pitch; int col; int rope; int wc0only; float* stat; int slot; };
__device__ __forceinline__ Route route(const Frame& F, int mode, int hh) {
    Route r; r.rope = 0; r.wc0only = 0; r.slot = 0; size_t off, soff = 0; int st = 0;
    if (mode == R_QKV0) { off = WS_QKV0; r.pitch = N0; r.col = hh * 128; }
    else if (mode == R_MD) {
        if (hh < 3) { off = WS_CQ; r.pitch = QRANK; r.col = hh * 128; st = 1; soff = WS_SQ; r.slot = hh * 4; }
        else if (hh == 3) { off = WS_KR; r.pitch = 32; r.col = 0; r.rope = 1; r.wc0only = 1; }
        else { off = WS_CKV; r.pitch = KVRANK; r.col = (hh - 4) * 128; st = 1; soff = WS_SKV; r.slot = (hh - 4) * 4; }
    } else if (mode == R_UQ) {
        if (hh < 8) { off = WS_QN; r.pitch = 1024; r.col = hh * 128; }
        else { off = WS_QR; r.pitch = 512; r.col = (hh - 8) * 128; r.rope = 1; }
    } else {
        if (hh < 8) { off = WS_KN; r.pitch = 1024; r.col = hh * 128; }
        else { off = WS_VV; r.pitch = 1024; r.col = (hh - 8) * 128; }
    }
    r.dst = (bf16*)(F.ws + off); r.stat = st ? (float*)(F.ws + soff) : nullptr;
    return r;
}

namespace pg8 {
#define PG8_LAS __attribute__((address_space(3)))
typedef unsigned short bf16_t;
typedef short bf16x8 __attribute__((ext_vector_type(8)));
typedef float f32x4 __attribute__((ext_vector_type(4)));
typedef unsigned u32x4 __attribute__((ext_vector_type(4)));
constexpr int BM = 256, BK = 64, HALF = 128, HTB = HALF * BK * 2  , STAGE_BYTES = 8 * HTB, NXCD = 8, WGM = 8;

__host__ __device__ __forceinline__ int lds_byte(int r, int c) { const int st = (r >> 4) * 2 + (c >> 5), rr = r & 15, cc = c & 31, ob = rr * 64 + cc * 2; return st * 1024 + (ob ^ (((ob >> 9) & 1) << 5)); }
__host__ __device__ __forceinline__ void stage_rc(int b, int& R, int& C) { const int st = b / 1024, sb = b % 1024, swz = sb ^ (((sb >> 9) & 1) << 5); R = (st >> 1) * 16 + swz / 64; C = (st & 1) * 32 + (swz % 64) / 2; }
__host__ __device__ __forceinline__ int perm32(int rho) { const int n = rho >> 4, i = rho & 15; return 8 * (i >> 2) + 4 * n + (i & 3); }

struct Unit { int pm, pn; };
struct Gemm { const bf16_t* A; const bf16_t* Bt; int M, N, K; };

struct StaticOrder {
    int nM, nN, nwg, G, c;
    __host__ __device__ void init(int M, int N, int G_, int c_) { nM = M / BM; nN = N / BM; nwg = nM * nN; G = G_; c = c_; }
    __host__ __device__ bool next(int i, Unit& u) const {
        const long L = (long)i * G + c; if (L >= nwg) return false;
        int wgid = (int)L; { const int q = nwg / NXCD, r = nwg % NXCD, xcd = wgid % NXCD, off = wgid / NXCD; wgid = (xcd < r ? xcd * (q + 1) : r * (q + 1) + (xcd - r) * q) + off; }
        const int nig = WGM * nN, gid = wgid / nig, fm = gid * WGM, gsz = (nM - fm) < WGM ? (nM - fm) : WGM;
        u.pm = fm + ((wgid % nig) % gsz); u.pn = (wgid % nig) / gsz; return true;
    }
    __device__ __forceinline__ void a_ready(const Unit&) const {}
    __device__ __forceinline__ void done(const Unit&) const {}
};

typedef __bf16 bf16x2_t __attribute__((ext_vector_type(2)));
typedef float f32x2v __attribute__((ext_vector_type(2)));
__device__ __forceinline__ unsigned cvtpk(float lo, float hi) { f32x2v v = {lo, hi}; bf16x2_t b = __builtin_convertvector(v, bf16x2_t); return __builtin_bit_cast(unsigned, b); }

struct EpiRowScale {
    static constexpr bool PERM = true, AFTER_DRAIN = false;
    const ::Frame* F; int rmode; const float* stat; int nslots; float inv_dim;
    __device__ __forceinline__ void operator()(const f32x4 (&acc)[2][2][4][2], const Unit& u, int wr, int wc, int fr, int fq) const {
        const int row0 = u.pm * BM + wr * 64 + fr;
        float rs[2][4];
#pragma unroll
        for (int ai = 0; ai < 2; ++ai)
#pragma unroll
            for (int m = 0; m < 4; ++m) rs[ai][m] = ::row_rstd(stat, row0 + ai * HALF + m * 16, nslots, inv_dim);
#pragma unroll
        for (int bj = 0; bj < 2; ++bj) {
            const ::Route rt = ::route(*F, rmode, u.pn * 2 + bj);
            if (rt.wc0only && wc != 0) continue;
#pragma unroll
            for (int ai = 0; ai < 2; ++ai)
#pragma unroll
                for (int m = 0; m < 4; ++m) {
                    const int row = row0 + ai * HALF + m * 16;
                    f32x4 v0 = acc[ai][bj][m][0] * rs[ai][m], v1 = acc[ai][bj][m][1] * rs[ai][m];
                    if (rt.stat) {
                        float ss = (v0[0] * v0[0] + v0[1] * v0[1]) + (v0[2] * v0[2] + v0[3] * v0[3]) + (v1[0] * v1[0] + v1[1] * v1[1]) + (v1[2] * v1[2] + v1[3] * v1[3]);
                        ss += __shfl_xor(ss, 16); ss += __shfl_xor(ss, 32);
                        if (fq == 0) rt.stat[(size_t)row * 16 + rt.slot + wc] = ss;
                    }
                    if (rt.rope) {
                        const f32x4* csp = (const f32x4*)(F->CS + (size_t)row * 16 + 8 * (fq & 1));
                        const f32x4 c0 = csp[0], c1 = csp[1], c2 = csp[2], c3 = csp[3];
                        f32x4 p0, p1;
#pragma unroll
                        for (int j = 0; j < 4; ++j) { p0[j] = __shfl_xor(v0[j], 32); p1[j] = __shfl_xor(v1[j], 32); }
                        const float sg = fq < 2 ? -1.0f : 1.0f;
                        v0[0] = v0[0] * c0[0] + sg * p0[0] * c0[1]; v0[1] = v0[1] * c0[2] + sg * p0[1] * c0[3]; v0[2] = v0[2] * c1[0] + sg * p0[2] * c1[1]; v0[3] = v0[3] * c1[2] + sg * p0[3] * c1[3];
                        v1[0] = v1[0] * c2[0] + sg * p1[0] * c2[1]; v1[1] = v1[1] * c2[2] + sg * p1[1] * c2[3]; v1[2] = v1[2] * c3[0] + sg * p1[2] * c3[1]; v1[3] = v1[3] * c3[2] + sg * p1[3] * c3[3];
                    }
                    u32x4 w; w.x = cvtpk(v0[0], v0[1]); w.y = cvtpk(v0[2], v0[3]); w.z = cvtpk(v1[0], v1[1]); w.w = cvtpk(v1[2], v1[3]);
                    *(u32x4*)(rt.dst + (size_t)row * rt.pitch + rt.col + wc * 32 + 8 * fq) = w;
                }
        }
    }
};
struct EpiSwiGLU {
    static constexpr bool PERM = true, AFTER_DRAIN = false;
    bf16_t* H; const float* stat; int nslots; float inv_dim;
    __device__ __forceinline__ void operator()(const f32x4 (&acc)[2][2][4][2], const Unit& u, int wr, int wc, int fr, int fq) const {
        const int row0 = u.pm * BM + wr * 64 + fr, col0 = u.pn * 128 + wc * 32 + 8 * fq;
#pragma unroll
        for (int ai = 0; ai < 2; ++ai)
#pragma unroll
            for (int m = 0; m < 4; ++m) {
                const int row = row0 + ai * HALF + m * 16; const float rs = ::row_rstd(stat, row, nslots, inv_dim);
                float hv[8];
#pragma unroll
                for (int n = 0; n < 2; ++n)
#pragma unroll
                    for (int j = 0; j < 4; ++j) { const float g = acc[ai][0][m][n][j] * rs, up = acc[ai][1][m][n][j] * rs;
                        hv[4 * n + j] = g * up * __builtin_amdgcn_rcpf(1.0f + __builtin_amdgcn_exp2f(-g * ::LOG2E)); }
                u32x4 w; w.x = cvtpk(hv[0], hv[1]); w.y = cvtpk(hv[2], hv[3]); w.z = cvtpk(hv[4], hv[5]); w.w = cvtpk(hv[6], hv[7]);
                *(u32x4*)(H + (size_t)row * ::FFH + col0) = w;
            }
    }
};
struct EpiResid {
    static constexpr bool PERM = false, AFTER_DRAIN = false;
    const float* base; float* xout; bf16_t* xn; float* stat_out;
    __device__ __forceinline__ void operator()(const f32x4 (&acc)[2][2][4][2], const Unit& u, int wr, int wc, int fr, int fq) const {
        const int row0 = u.pm * BM + wr * 64 + fr, col0 = u.pn * BM + wc * 32 + 4 * fq;
#pragma unroll
        for (int ai = 0; ai < 2; ++ai)
#pragma unroll
            for (int m = 0; m < 4; ++m) {
                const int row = row0 + ai * HALF + m * 16; const size_t ro = (size_t)row * ::DM + col0; float ss = 0.f;
#pragma unroll
                for (int bj = 0; bj < 2; ++bj)
#pragma unroll
                    for (int n = 0; n < 2; ++n) { const size_t o = ro + bj * HALF + n * 16; const f32x4 v = *(const f32x4*)(base + o) + acc[ai][bj][m][n];
                        *(f32x4*)(xout + o) = v; ss += (v[0] * v[0] + v[1] * v[1]) + (v[2] * v[2] + v[3] * v[3]);
                        if (xn) { typedef unsigned u32x2v __attribute__((ext_vector_type(2))); *(u32x2v*)(xn + o) = (u32x2v){cvtpk(v[0], v[1]), cvtpk(v[2], v[3])}; } }
                ss += __shfl_xor(ss, 16); ss += __shfl_xor(ss, 32);
                if (fq == 0) stat_out[(size_t)row * 16 + u.pn * 4 + wc] = ss;
            }
    }
};

template <class Epi, class Sched, bool ALIGN_EPI = false, bool SP2 = false>
__device__ __forceinline__ void gemm_phase(PG8_LAS unsigned char* lds, const Gemm g, const Sched& S, const Epi& E) {
    int tid; asm volatile("v_mov_b32 %0, %1" : "=v"(tid) : "v"(threadIdx.x));
    const int wid = __builtin_amdgcn_readfirstlane(tid >> 6), lane = tid & 63, wr = wid >> 2, wc = wid & 3, fr = lane & 15, fq = lane >> 4;
    const int K = g.K, nt = K / BK;
    unsigned voffA[2], voffB[2];
#pragma unroll
    for (int i = 0; i < 2; ++i) { int R, C; stage_rc(tid * 16 + i * 8192, R, C); const int Rb = Epi::PERM ? ((R & ~31) + perm32(R & 31)) : R;
        voffA[i] = (unsigned)(R * K + C) * 2u; voffB[i] = (unsigned)(Rb * K + C) * 2u; }
    const size_t kstep = (size_t)(BK * 2);
    const size_t hstep = (size_t)HALF * K * 2;
    const size_t tstep = 2 * hstep;
    const unsigned ldsw = (unsigned)wid * 1024u;
    const int aoff = lds_byte(wr * 64 + fr, fq * 8), boff = lds_byte(wc * 32 + fr, fq * 8);
#define PG8_SA(b, h) (((b) * 2 + (h)) * HTB)
#define PG8_SB(b, h) ((4 + (b) * 2 + (h)) * HTB)
#define PG8_STAGE(bufoff, gbase, voff) do { _Pragma("unroll") for (int _i = 0; _i < 2; ++_i) \
        __builtin_amdgcn_global_load_lds((const unsigned*)((const char*)(gbase) + (voff)[_i]), (PG8_LAS unsigned*)(lds + (bufoff) + ldsw + _i * 8192), 16, 0, 0); } while (0)
#define PG8_LDA(dst, b, h) do { _Pragma("unroll") for (int m = 0; m < 4; ++m) _Pragma("unroll") for (int k = 0; k < 2; ++k) dst[m][k] = *(const PG8_LAS bf16x8*)(lds + PG8_SA(b, h) + aoff + m * 2048 + k * 1024); } while (0)
#define PG8_LDB(dst, b, h) do { _Pragma("unroll") for (int n = 0; n < 2; ++n) _Pragma("unroll") for (int k = 0; k < 2; ++k) dst[n][k] = *(const PG8_LAS bf16x8*)(lds + PG8_SB(b, h) + boff + n * 2048 + k * 1024); } while (0)
#define PG8_MMA(ai, bj, At, Bt) do { __builtin_amdgcn_s_setprio(1); _Pragma("unroll") for (int m = 0; m < 4; ++m) _Pragma("unroll") for (int n = 0; n < 2; ++n) _Pragma("unroll") for (int k = 0; k < 2; ++k) \
        acc[ai][bj][m][n] = __builtin_amdgcn_mfma_f32_16x16x32_bf16(Bt[n][k], At[m][k], acc[ai][bj][m][n], 0, 0, 0); __builtin_amdgcn_s_setprio(0); } while (0)
#define PG8_WAIT_V(n) asm volatile("s_waitcnt vmcnt(" #n ")" ::: "memory")
#define PG8_WAIT_L(n) asm volatile("s_waitcnt lgkmcnt(" #n ")" ::: "memory")
#define PG8_BAR __builtin_amdgcn_s_barrier()
#define PG8_SCHED __builtin_amdgcn_sched_barrier(0)
    Unit cur, nxt; int ui = 0;
    if (!S.next(0, cur)) return;
    f32x4 acc[2][2][4][2];
#pragma unroll
    for (int a = 0; a < 2; ++a)
#pragma unroll
        for (int b = 0; b < 2; ++b)
#pragma unroll
            for (int m = 0; m < 4; ++m)
#pragma unroll
                for (int n = 0; n < 2; ++n) acc[a][b][m][n] = (f32x4){0.f, 0.f, 0.f, 0.f};
    bf16x8 At[4][2], B0[2][2], B1[2][2];
    const char* cA = (const char*)g.A + (size_t)cur.pm * tstep; const char* cB = (const char*)g.Bt + (size_t)cur.pn * tstep;
    S.a_ready(cur);
    if constexpr (SP2) {
        PG8_STAGE(PG8_SB(0, 0), cB, voffB); PG8_STAGE(PG8_SB(0, 1), cB + hstep, voffB); PG8_STAGE(PG8_SA(0, 0), cA, voffA); PG8_STAGE(PG8_SA(0, 1), cA + hstep, voffA);
        if (wr == 1) PG8_BAR;
        PG8_WAIT_V(2); PG8_BAR;
        PG8_STAGE(PG8_SB(1, 0), cB + kstep, voffB); PG8_STAGE(PG8_SA(1, 0), cA + kstep, voffA); PG8_STAGE(PG8_SB(1, 1), cB + hstep + kstep, voffB);
        PG8_WAIT_V(6); PG8_BAR;
    } else {
        PG8_STAGE(PG8_SB(0, 0), cB, voffB); PG8_STAGE(PG8_SA(0, 0), cA, voffA); PG8_STAGE(PG8_SB(0, 1), cB + hstep, voffB); PG8_STAGE(PG8_SA(0, 1), cA + hstep, voffA);
        if (wr == 1) PG8_BAR;
        PG8_WAIT_V(4); PG8_BAR;
        PG8_STAGE(PG8_SB(1, 0), cB + kstep, voffB); PG8_STAGE(PG8_SA(1, 0), cA + kstep, voffA); PG8_STAGE(PG8_SB(1, 1), cB + hstep + kstep, voffB);
        PG8_WAIT_V(6); PG8_BAR;
    }
    for (;;) {
        const bool has_next = S.next(ui + 1, nxt);
        const char* nA = has_next ? (const char*)g.A + (size_t)nxt.pm * tstep : cA; const char* nB = has_next ? (const char*)g.Bt + (size_t)nxt.pn * tstep : cB;
        for (int t = 0; t < nt; t += 2) {
            const bool last = (t == nt - 2);
            const char* a1 = cA + (size_t)(t + 1) * kstep;
            const char* a2 = last ? nA : cA + (size_t)(t + 2) * kstep; const char* b2 = last ? nB : cB + (size_t)(t + 2) * kstep;
            const char* a3 = a2 + kstep; const char* b3 = b2 + kstep;
            if (last && has_next) S.a_ready(nxt);
            if constexpr (SP2) {
            PG8_LDB(B0, 0, 0); PG8_LDB(B1, 0, 1); PG8_SCHED; PG8_LDA(At, 0, 0); PG8_STAGE(PG8_SA(1, 1), a1 + hstep, voffA);
            PG8_WAIT_V(8); PG8_WAIT_L(0); PG8_BAR; PG8_MMA(0, 0, At, B0); PG8_MMA(0, 1, At, B1); PG8_BAR; PG8_SCHED;
            PG8_LDA(At, 0, 1); PG8_STAGE(PG8_SB(0, 0), b2, voffB); PG8_STAGE(PG8_SB(0, 1), b2 + hstep, voffB); PG8_STAGE(PG8_SA(0, 0), a2, voffA);
            PG8_WAIT_V(8); PG8_WAIT_L(0); PG8_BAR; PG8_MMA(1, 0, At, B0); PG8_MMA(1, 1, At, B1); PG8_BAR; PG8_SCHED;
            PG8_LDB(B0, 1, 0); PG8_LDB(B1, 1, 1); PG8_SCHED; PG8_LDA(At, 1, 0); PG8_STAGE(PG8_SA(0, 1), a2 + hstep, voffA);
            PG8_WAIT_V(8); PG8_WAIT_L(0); PG8_BAR; PG8_MMA(0, 0, At, B0); PG8_MMA(0, 1, At, B1); PG8_BAR; PG8_SCHED;
            PG8_LDA(At, 1, 1); PG8_STAGE(PG8_SB(1, 0), b3, voffB); PG8_STAGE(PG8_SB(1, 1), b3 + hstep, voffB); PG8_STAGE(PG8_SA(1, 0), a3, voffA);
            PG8_WAIT_V(8); PG8_WAIT_L(0); PG8_BAR; PG8_MMA(1, 0, At, B0); PG8_MMA(1, 1, At, B1); PG8_BAR; PG8_SCHED;
            } else {
            PG8_LDB(B0, 0, 0); PG8_SCHED; PG8_LDA(At, 0, 0); PG8_STAGE(PG8_SA(1, 1), a1 + hstep, voffA);
            PG8_WAIT_L(8); PG8_BAR; PG8_WAIT_L(0); PG8_MMA(0, 0, At, B0); PG8_BAR; PG8_SCHED;
            PG8_LDB(B1, 0, 1); PG8_STAGE(PG8_SB(0, 0), b2, voffB);
            PG8_BAR; PG8_WAIT_L(0); PG8_MMA(0, 1, At, B1); PG8_BAR;
            PG8_LDA(At, 0, 1); PG8_STAGE(PG8_SA(0, 0), a2, voffA);
            PG8_BAR; PG8_WAIT_L(0); PG8_MMA(1, 0, At, B0); PG8_BAR; PG8_SCHED;
            PG8_STAGE(PG8_SB(0, 1), b2 + hstep, voffB);
            PG8_WAIT_V(6); PG8_BAR; PG8_MMA(1, 1, At, B1); PG8_BAR;
            PG8_LDB(B0, 1, 0); PG8_SCHED; PG8_LDA(At, 1, 0); PG8_STAGE(PG8_SA(0, 1), a2 + hstep, voffA);
            PG8_WAIT_L(8); PG8_BAR; PG8_WAIT_L(0); PG8_MMA(0, 0, At, B0); PG8_BAR; PG8_SCHED;
            PG8_LDB(B1, 1, 1); PG8_STAGE(PG8_SB(1, 0), b3, voffB);
            PG8_BAR; PG8_WAIT_L(0); PG8_MMA(0, 1, At, B1); PG8_BAR;
            PG8_LDA(At, 1, 1); PG8_STAGE(PG8_SA(1, 0), a3, voffA);
            PG8_BAR; PG8_WAIT_L(0); PG8_MMA(1, 0, At, B0); PG8_BAR; PG8_SCHED;
            PG8_STAGE(PG8_SB(1, 1), b3 + hstep, voffB);
            PG8_WAIT_V(6); PG8_BAR; PG8_MMA(1, 1, At, B1); PG8_BAR;
            }
        }
        if constexpr (ALIGN_EPI) { if (wr == 0) PG8_BAR; }
        if constexpr (!Epi::AFTER_DRAIN) { E(acc, cur, wr, wc, fr, fq); S.done(cur); }
        if (!has_next) break;
#pragma unroll
        for (int a = 0; a < 2; ++a)
#pragma unroll
            for (int b = 0; b < 2; ++b)
#pragma unroll
                for (int m = 0; m < 4; ++m)
#pragma unroll
                    for (int n = 0; n < 2; ++n) acc[a][b][m][n] = (f32x4){0.f, 0.f, 0.f, 0.f};
        cur = nxt; cA = nA; cB = nB; ++ui;
        if constexpr (ALIGN_EPI) { if (wr == 1) PG8_BAR; }
    }
    PG8_WAIT_V(0);
    if constexpr (!ALIGN_EPI) { if (wr == 0) PG8_BAR; }
    PG8_BAR;
    if constexpr (Epi::AFTER_DRAIN) { E.fused(acc, cur, wr, wc, fr, fq, lds, wid, lane); S.done(cur); }
#undef PG8_SA
#undef PG8_SB
#undef PG8_STAGE
#undef PG8_LDA
#undef PG8_LDB
#undef PG8_MMA
#undef PG8_WAIT_V
#undef PG8_WAIT_L
#undef PG8_BAR
#undef PG8_SCHED
}
}

enum { WM_IN = 0, WM_PLAIN = 1, WM_GATE = 2, WM_UP = 3, WM_MD = 4, WM_UQ = 5, WM_UKV = 6 };
__device__ __forceinline__ int wmap_row(int mode, int n) {
    switch (mode) {
        case WM_GATE: return (n >> 7) * 256 + (n & 127);
        case WM_UP: return (n >> 7) * 256 + 128 + (n & 127);
        case WM_MD: return n < 384 ? n : (n < 640 ? n + 128 : n - 256);
        case WM_UQ: { const int h = n / 96, e = n % 96; return e < 64 ? h * 64 + e : 1024 + h * 32 + (e - 64); }
        case WM_UKV: { const int h = n >> 7, e = n & 127; return e < 64 ? h * 64 + e : 1024 + h * 64 + (e - 64); }
        default: return n;
    }
}
__device__ __forceinline__ float wmap_scale(int mode, int n) {
    if (mode == WM_IN) return (n < 512 || (n >= 1536 && n < 2048)) ? 0.125f * LOG2E : 1.0f;
    if (mode == WM_UQ) return 0.10206207261596577f * LOG2E;
    return 1.0f;
}
__device__ __forceinline__ void p0_transpose_item(const float* W, const float* gain, int K, int N, bf16* WT, int mode, LAS float* scr, int item, int lane) {
    const int nblk = N / 32, kb = item / nblk, nb = item % nblk, k0 = 64 * kb, n0 = 32 * nb;
#pragma unroll 8
    for (int i = 0; i < 32; ++i) { const int kk = 2 * i + (lane >> 5); const float g = gain ? gain[k0 + kk] : 1.0f; scr[kk * 33 + (lane & 31)] = W[(size_t)(k0 + kk) * N + n0 + (lane & 31)] * g; }
    asm volatile("s_waitcnt lgkmcnt(0)" ::: "memory");
    const int c = lane & 7;
#pragma unroll
    for (int j = 0; j < 4; ++j) { const int n = (lane >> 3) + 8 * j; const LAS float* s = scr + (8 * c) * 33 + n; const float sc = wmap_scale(mode, n0 + n);
        u32x4 o; o.x = pk2(s[0 * 33] * sc, s[1 * 33] * sc); o.y = pk2(s[2 * 33] * sc, s[3 * 33] * sc); o.z = pk2(s[4 * 33] * sc, s[5 * 33] * sc); o.w = pk2(s[6 * 33] * sc, s[7 * 33] * sc);
        *(u32x4*)(WT + (size_t)wmap_row(mode, n0 + n) * K + k0 + 8 * c) = o; }
    asm volatile("s_waitcnt lgkmcnt(0)" ::: "memory");
}
struct WJob { const float* W; const float* gain; int K, N; bf16* WT; int mode; };
__device__ __forceinline__ WJob wjob(const Frame& F, int j) {
    switch (j) {
        case 0: return WJob{F.w_in, F.attn_norm, DM, N0, F.W_IN, WM_IN};
        case 1: return WJob{F.w_out, nullptr, DM, DM, F.W_OUT, WM_PLAIN};
        case 2: return WJob{F.w_gate, F.ffn_norm, DM, FFH, F.W_GU0, WM_GATE};
        case 3: return WJob{F.w_up, F.ffn_norm, DM, FFH, F.W_GU0, WM_UP};
        case 4: return WJob{F.w_down, nullptr, FFH, DM, F.W_DN0, WM_PLAIN};
        case 5: return WJob{F.w_md, F.attn_norm + DM, DM, 672, F.W_MD, WM_MD};
        case 6: return WJob{F.w_uq, F.q_norm, QRANK, NUQ, F.W_UQ, WM_UQ};
        case 7: return WJob{F.w_ukv, F.kv_norm, KVRANK, NUKV, F.W_UKV, WM_UKV};
        case 8: return WJob{F.w_o, nullptr, DM, DM, F.W_O, WM_PLAIN};
        case 9: return WJob{F.w_gate + (size_t)DM * FFH, F.ffn_norm + DM, DM, FFH, F.W_GU1, WM_GATE};
        case 10: return WJob{F.w_up + (size_t)DM * FFH, F.ffn_norm + DM, DM, FFH, F.W_GU1, WM_UP};
        default: return WJob{F.w_down + (size_t)FFH * DM, nullptr, FFH, DM, F.W_DN1, WM_PLAIN};
    }
}
__device__ __forceinline__ void p0_prologue(const Frame& F, LAS unsigned char* lds) {
    LAS float* scr = (LAS float*)(lds + F.wave * 16384);
    const int gw = F.bid * NWAVES + F.wave, NGW = F.G * NWAVES;
    for (int j = 0; j < 12; ++j) { const WJob w = wjob(F, j); const int items = (w.K / 64) * (w.N / 32);
        for (int it = gw; it < items; it += NGW) p0_transpose_item(w.W, w.gain, w.K, w.N, w.WT, w.mode, scr, it, F.lane); }
    for (int i = gw * 64 + F.lane; i < 96 * DM / 8; i += NGW * 64) *(u32x4*)(F.W_MD + (size_t)416 * DM + (size_t)i * 8) = (u32x4){0u, 0u, 0u, 0u};
    for (int m = gw; m < M; m += NGW) {
        const f32x4* xr = (const f32x4*)(F.x + (size_t)m * DM) + F.lane; f32x4 v[4]; float s = 0.f;
#pragma unroll
        for (int j = 0; j < 4; ++j) { v[j] = xr[64 * j]; s += (v[j].x * v[j].x + v[j].y * v[j].y) + (v[j].z * v[j].z + v[j].w * v[j].w); }
        s = wave_sum(s);
        u32x2* o8 = (u32x2*)(F.XN + (size_t)m * DM) + F.lane;
#pragma unroll
        for (int j = 0; j < 4; ++j) o8[64 * j] = (u32x2){pk2(v[j].x, v[j].y), pk2(v[j].z, v[j].w)};
        if (F.lane < 16) F.ST[(size_t)m * 16 + F.lane] = F.lane == 0 ? s : 0.f;
    }
    { f32x4* z = (f32x4*)(F.ST + (size_t)M * 16); const int n4 = 6 * M * 16 / 4;
      for (int i = gw * 64 + F.lane; i < n4; i += NGW * 64) z[i] = (f32x4){0.f, 0.f, 0.f, 0.f}; }
    for (int e = gw * 64 + F.lane; e < M * 16; e += NGW * 64) {
        const int row = e >> 4, i = e & 15;
        const float freq = exp2f(-(float)i * 0.83048202372184059f);
        const float ang = (float)F.pos[row] * freq;
        const float nrev = rintf(ang * 0.15915494309189535f);
        float r = fmaf(-nrev, 6.28125f, ang); r = fmaf(-nrev, 0.0019353071795864769f, r);
        const float rf = r * 0.15915494309189535f;
        F.CS[e] = (f32x2){__builtin_amdgcn_cosf(rf), __builtin_amdgcn_sinf(rf)};
    }
}

enum { G_ROWSCALE = 0, G_SWIGLU = 1, G_RESID = 2 };
struct GemmDesc { const bf16* A; const bf16* Bt; int N, K; int kind; int rmode; const float* stat; int nslots; float inv_dim; const float* base; float* xout; bf16* xn; float* stat_out; bf16* hout; };

__device__ __forceinline__ void naive_gemm_phase(const Frame& F, const GemmDesc g) {
    const int lane = F.lane, fr = lane & 15, fq = lane >> 4;
    const int gw = F.bid * NWAVES + F.wave, NGW = F.G * NWAVES;
    const int K = g.K;
    if (g.kind == G_SWIGLU) {
        const int ncb = FFH / 32, units = (M / 32) * ncb;
        for (int u = gw; u < units; u += NGW) {
            const int r0 = (u / ncb) * 32, j0 = (u % ncb) * 32;
            const int brow = (j0 >> 7) * 256 + (j0 & 127);
            f32x4 ag[2][2], au[2][2];
#pragma unroll
            for (int a = 0; a < 2; ++a)
#pragma unroll
                for (int b = 0; b < 2; ++b) { ag[a][b] = (f32x4){0.f, 0.f, 0.f, 0.f}; au[a][b] = (f32x4){0.f, 0.f, 0.f, 0.f}; }
            for (int k0 = 0; k0 < K; k0 += 32) {
                bf16x8 af[2], bg[2], bu[2];
#pragma unroll
                for (int a = 0; a < 2; ++a) af[a] = *(const bf16x8*)(g.A + (size_t)(r0 + 16 * a + fr) * K + k0 + 8 * fq);
#pragma unroll
                for (int b = 0; b < 2; ++b) { bg[b] = *(const bf16x8*)(g.Bt + (size_t)(brow + 16 * b + fr) * K + k0 + 8 * fq); bu[b] = *(const bf16x8*)(g.Bt + (size_t)(brow + 128 + 16 * b + fr) * K + k0 + 8 * fq); }
#pragma unroll
                for (int a = 0; a < 2; ++a)
#pragma unroll
                    for (int b = 0; b < 2; ++b) { ag[a][b] = __builtin_amdgcn_mfma_f32_16x16x32_bf16(af[a], bg[b], ag[a][b], 0, 0, 0); au[a][b] = __builtin_amdgcn_mfma_f32_16x16x32_bf16(af[a], bu[b], au[a][b], 0, 0, 0); }
            }
#pragma unroll
            for (int a = 0; a < 2; ++a)
#pragma unroll
                for (int r = 0; r < 4; ++r) { const int row = r0 + 16 * a + 4 * fq + r; const float rs = row_rstd(g.stat, row, g.nslots, g.inv_dim);
#pragma unroll
                    for (int b = 0; b < 2; ++b) { const float gv = ag[a][b][r] * rs, uv = au[a][b][r] * rs; const float hv = gv * uv / (1.0f + __builtin_amdgcn_exp2f(-gv * LOG2E));
                        g.hout[(size_t)row * FFH + j0 + 16 * b + fr] = (bf16)f2bf(hv); } }
        }
        return;
    }
    const int ncb = g.N / 64, units = (M / 32) * ncb;
    for (int u = gw; u < units; u += NGW) {
        const int r0 = (u / ncb) * 32, c0 = (u % ncb) * 64;
        f32x4 acc[2][4];
#pragma unroll
        for (int a = 0; a < 2; ++a)
#pragma unroll
            for (int b = 0; b < 4; ++b) acc[a][b] = (f32x4){0.f, 0.f, 0.f, 0.f};
        for (int k0 = 0; k0 < K; k0 += 32) {
            bf16x8 af[2], bfr[4];
#pragma unroll
            for (int a = 0; a < 2; ++a) af[a] = *(const bf16x8*)(g.A + (size_t)(r0 + 16 * a + fr) * K + k0 + 8 * fq);
#pragma unroll
            for (int b = 0; b < 4; ++b) bfr[b] = *(const bf16x8*)(g.Bt + (size_t)(c0 + 16 * b + fr) * K + k0 + 8 * fq);
#pragma unroll
            for (int a = 0; a < 2; ++a)
#pragma unroll
                for (int b = 0; b < 4; ++b) acc[a][b] = __builtin_amdgcn_mfma_f32_16x16x32_bf16(af[a], bfr[b], acc[a][b], 0, 0, 0);
        }
        if (g.kind == G_RESID) {
#pragma unroll
            for (int a = 0; a < 2; ++a)
#pragma unroll
                for (int r = 0; r < 4; ++r) { const int row = r0 + 16 * a + 4 * fq + r; float ss = 0.f;
#pragma unroll
                    for (int b = 0; b < 4; ++b) { const int col = c0 + 16 * b + fr; const size_t o = (size_t)row * DM + col; const float v = g.base[o] + acc[a][b][r]; g.xout[o] = v; if (g.xn) g.xn[o] = (bf16)f2bf(v); ss += v * v; }
                    ss += __shfl_xor(ss, 1); ss += __shfl_xor(ss, 2); ss += __shfl_xor(ss, 4); ss += __shfl_xor(ss, 8);
                    if (fr == 0) atomicAdd(g.stat_out + (size_t)row * 16, ss); }
        } else {
            const int hh = c0 >> 7; const Route rt = route(F, g.rmode, hh); const int cin = c0 & 127;
            if (rt.wc0only && cin != 0) continue;
#pragma unroll
            for (int a = 0; a < 2; ++a)
#pragma unroll
                for (int r = 0; r < 4; ++r) { const int row = r0 + 16 * a + 4 * fq + r; const float rs = row_rstd(g.stat, row, g.nslots, g.inv_dim);
                    float v[4]; float ss = 0.f;
#pragma unroll
                    for (int b = 0; b < 4; ++b) { v[b] = acc[a][b][r] * rs; ss += v[b] * v[b]; }
                    if (rt.rope) { const f32x2 cs = F.CS[(size_t)row * 16 + fr];
#pragma unroll
                        for (int p = 0; p < 2; ++p) { const float x1 = v[2 * p], x2 = v[2 * p + 1]; v[2 * p] = x1 * cs.x - x2 * cs.y; v[2 * p + 1] = x2 * cs.x + x1 * cs.y; } }
#pragma unroll
                    for (int b = 0; b < 4; ++b) { if (rt.wc0only && b >= 2) break; rt.dst[(size_t)row * rt.pitch + rt.col + cin + 16 * b + fr] = (bf16)f2bf(v[b]); }
                    if (rt.stat) { ss += __shfl_xor(ss, 1); ss += __shfl_xor(ss, 2); ss += __shfl_xor(ss, 4); ss += __shfl_xor(ss, 8); if (fr == 0) atomicAdd(rt.stat + (size_t)row * 16, ss); } }
        }
    }
}

__device__ __forceinline__ float dot8(const float* q, const u32x4 c) {
    return q[0] * __builtin_bit_cast(float, c.x << 16) + q[1] * __builtin_bit_cast(float, c.x & 0xffff0000u) + q[2] * __builtin_bit_cast(float, c.y << 16) + q[3] * __builtin_bit_cast(float, c.y & 0xffff0000u)
         + q[4] * __builtin_bit_cast(float, c.z << 16) + q[5] * __builtin_bit_cast(float, c.z & 0xffff0000u) + q[6] * __builtin_bit_cast(float, c.w << 16) + q[7] * __builtin_bit_cast(float, c.w & 0xffff0000u);
}
__device__ __forceinline__ void axpy8(float* o, float al, float p, const u32x4 c) {
    o[0] = o[0] * al + p * __builtin_bit_cast(float, c.x << 16); o[1] = o[1] * al + p * __builtin_bit_cast(float, c.x & 0xffff0000u);
    o[2] = o[2] * al + p * __builtin_bit_cast(float, c.y << 16); o[3] = o[3] * al + p * __builtin_bit_cast(float, c.y & 0xffff0000u);
    o[4] = o[4] * al + p * __builtin_bit_cast(float, c.z << 16); o[5] = o[5] * al + p * __builtin_bit_cast(float, c.z & 0xffff0000u);
    o[6] = o[6] * al + p * __builtin_bit_cast(float, c.w << 16); o[7] = o[7] * al + p * __builtin_bit_cast(float, c.w & 0xffff0000u);
}
__device__ __forceinline__ void naive_sb(const Frame& F) {
    const int gw = F.bid * NWAVES + F.wave, NGW = F.G * NWAVES;
    for (int u = gw; u < BATCH * 8 * (SEQ / 64); u += NGW) {
        const int blk = u % (SEQ / 64), h = (u / (SEQ / 64)) % 8, b = u / (SEQ / 64 * 8);
        const int t = blk * 64 + F.lane; const size_t rowq = (size_t)b * SEQ + t;
        float q[64], o[64];
#pragma unroll
        for (int d = 0; d < 64; ++d) { q[d] = bf2f(F.QKV0[rowq * N0 + h * 64 + d]); o[d] = 0.f; }
        float carry = 0.f;
        for (int s = blk * 64 + 63; s >= 0; --s) {
            const bf16* kr = F.QKV0 + ((size_t)b * SEQ + s) * N0 + 512 + h * 64; const bf16* vr = kr + 512;
            float y = 0.f;
#pragma unroll
            for (int d = 0; d < 8; ++d) y += dot8(q + 8 * d, ((const u32x4*)kr)[d]);
            const bool valid = s < t;
            const float sp = fmaxf(y, 0.f) + __builtin_amdgcn_logf(1.0f + __builtin_amdgcn_exp2f(-fabsf(y)));
            const float w = valid ? __builtin_amdgcn_exp2f((y - sp) + carry) : 0.f;
            if (valid) carry -= sp;
#pragma unroll
            for (int d = 0; d < 8; ++d) axpy8(o + 8 * d, 1.0f, w, ((const u32x4*)vr)[d]);
        }
#pragma unroll
        for (int d = 0; d < 64; ++d) F.AO[rowq * DM + h * 64 + d] = (bf16)f2bf(o[d]);
    }
}
__device__ __forceinline__ float t5_bias2(const Frame& F, int rel, int h) {
    int bk = rel;
    if (rel >= 16) { bk = 16 + (int)(log2f((float)rel * 0.0625f) * (16.0f / 3.0f)); bk = bk > 31 ? 31 : bk; }
    return F.relb[bk * 8 + h] * LOG2E;
}
__device__ __forceinline__ void naive_swa(const Frame& F) {
    const int gw = F.bid * NWAVES + F.wave, NGW = F.G * NWAVES;
    for (int u = gw; u < BATCH * 8 * (SEQ / 64); u += NGW) {
        const int blk = u % (SEQ / 64), h = (u / (SEQ / 64)) % 8, b = u / (SEQ / 64 * 8), kvh = h >> 2;
        const int t = blk * 64 + F.lane; const size_t rowq = (size_t)b * SEQ + t;
        float q[64], o[64];
#pragma unroll
        for (int d = 0; d < 64; ++d) { q[d] = bf2f(F.QKV0[rowq * N0 + 1536 + h * 64 + d]); o[d] = 0.f; }
        float m = F.sinks[h] * LOG2E, l = 1.0f;
        const int s_lo = blk * 64 - 127 < 0 ? 0 : blk * 64 - 127;
        for (int s = s_lo; s <= blk * 64 + 63; ++s) {
            const bf16* kr = F.QKV0 + ((size_t)b * SEQ + s) * N0 + 2048 + kvh * 64; const bf16* vr = kr + 128;
            float y = 0.f;
#pragma unroll
            for (int d = 0; d < 8; ++d) y += dot8(q + 8 * d, ((const u32x4*)kr)[d]);
            const int rel = t - s; const bool valid = rel >= 0 && rel < 128;
            const float lg = valid ? y + t5_bias2(F, rel & 127, h) : -INFINITY;
            const float mn = fmaxf(m, lg), al = __builtin_amdgcn_exp2f(m - mn), p = __builtin_amdgcn_exp2f(lg - mn);
            l = l * al + p; m = mn;
#pragma unroll
            for (int d = 0; d < 8; ++d) axpy8(o + 8 * d, al, p, ((const u32x4*)vr)[d]);
        }
        const float il = 1.0f / l;
#pragma unroll
        for (int d = 0; d < 64; ++d) F.AO[rowq * DM + 512 + h * 64 + d] = (bf16)f2bf(o[d] * il);
    }
}
__device__ __forceinline__ void naive_mla(const Frame& F) {
    const int gw = F.bid * NWAVES + F.wave, NGW = F.G * NWAVES;
    for (int u = gw; u < BATCH * 16 * (SEQ / 64); u += NGW) {
        const int blk = (SEQ / 64 - 1) - u % (SEQ / 64), h = (u / (SEQ / 64)) % 16, b = u / (SEQ / 64 * 16);
        const int t = blk * 64 + F.lane; const size_t rowq = (size_t)b * SEQ + t;
        float q[96], o[64];
#pragma unroll
        for (int d = 0; d < 64; ++d) { q[d] = bf2f(F.QN[rowq * 1024 + h * 64 + d]); o[d] = 0.f; }
#pragma unroll
        for (int d = 0; d < 32; ++d) q[64 + d] = bf2f(F.QR[rowq * 512 + h * 32 + d]);
        float m = -1e30f, l = 0.f;
        for (int s = 0; s <= blk * 64 + 63; ++s) {
            const size_t rk = (size_t)b * SEQ + s; const bf16* kn = F.KN + rk * 1024 + h * 64; const bf16* kr = F.KR + rk * 32; const bf16* vr = F.VV + rk * 1024 + h * 64;
            float y = 0.f;
#pragma unroll
            for (int d = 0; d < 8; ++d) y += dot8(q + 8 * d, ((const u32x4*)kn)[d]);
#pragma unroll
            for (int d = 0; d < 4; ++d) y += dot8(q + 64 + 8 * d, ((const u32x4*)kr)[d]);
            const float lg = s <= t ? y : -INFINITY;
            const float mn = fmaxf(m, lg), al = __builtin_amdgcn_exp2f(m - mn), p = __builtin_amdgcn_exp2f(lg - mn);
            l = l * al + p; m = mn;
#pragma unroll
            for (int d = 0; d < 8; ++d) axpy8(o + 8 * d, al, p, ((const u32x4*)vr)[d]);
        }
        const float il = 1.0f / l;
#pragma unroll
        for (int d = 0; d < 64; ++d) F.AO[rowq * DM + h * 64 + d] = (bf16)f2bf(o[d] * il);
    }
}
__device__ __forceinline__ void final_norm_phase(const Frame& F) {
    const int gw = F.bid * NWAVES + F.wave, NGW = F.G * NWAVES;
    for (int m = gw; m < M; m += NGW) {
        const float rs = row_rstd(F.ST + (size_t)4 * M * 16, m, 16, 1.0f / DM);
        f32x4* xr = (f32x4*)(F.out + (size_t)m * DM) + F.lane; const f32x4* gr = (const f32x4*)F.final_norm + F.lane;
#pragma unroll
        for (int j = 0; j < 4; ++j) { const f32x4 v = xr[64 * j], g = gr[64 * j]; xr[64 * j] = v * rs * g; }
    }
}

namespace att {
typedef float f32x16 __attribute__((ext_vector_type(16)));
typedef short v4i16_t __attribute__((ext_vector_type(4)));
typedef __bf16 bf16x2_t __attribute__((ext_vector_type(2)));
constexpr int NSLOT = 3, SLOT_K = 12288, SLOT_V = 8192, OFF_K = 0, OFF_V = NSLOT * SLOT_K, OFF_FLAG = OFF_V + NSLOT * SLOT_V, OFF_TB = OFF_FLAG + 64, ATT_LDS = OFF_TB + 512;
__device__ __forceinline__ unsigned cvtpk(float lo, float hi) { f32x2 v = {lo, hi}; bf16x2_t b = __builtin_convertvector(v, bf16x2_t); return __builtin_bit_cast(unsigned, b); }
__device__ __forceinline__ void glds16(const void* gsrc, unsigned lds_dst) { unsigned keep;
    asm volatile("s_mov_b32 %0, m0\n\ts_mov_b32 m0, %2\n\ts_nop 0\n\tglobal_load_lds_dwordx4 %1, off\n\ts_mov_b32 m0, %0" : "=&s"(keep) : "v"(gsrc), "s"(lds_dst) : "memory"); }
#define ATT_WAIT_BAR(N) asm volatile("s_waitcnt vmcnt(" #N ") lgkmcnt(0)\n\ts_barrier" ::: "memory")
__device__ __forceinline__ int crow(int r, int hi) { return (r & 3) + 8 * (r >> 2) + 4 * hi; }

template <int MODE> __device__ __forceinline__ void attn_unit(const Frame& F, LAS unsigned char* lds, int b, int h, int qb) {
    const int tid = F.tid, lane = F.lane, wid = F.wave, r32 = lane & 31, hi = lane >> 5;
    constexpr int ND2 = MODE == 2 ? 6 : 4;
    const int q0 = qb * 256, qw0 = q0 + 32 * wid, qg = qw0 + r32;
    const size_t rowq = (size_t)b * SEQ + qg, rowb = (size_t)b * SEQ;
    const bf16 *Qp, *Qr = nullptr, *Kb, *Vb, *KRb = nullptr; int pK, pV; bf16* Op;
    if (MODE == 0) { Qp = F.QKV0 + rowq * N0 + h * 64; Kb = F.QKV0 + rowb * N0 + 512 + h * 64; Vb = Kb + 512; pK = pV = N0; Op = F.AO + rowq * DM + h * 64; }
    else if (MODE == 1) { Qp = F.QKV0 + rowq * N0 + 1536 + h * 64; Kb = F.QKV0 + rowb * N0 + 2048 + (h >> 2) * 64; Vb = Kb + 128; pK = pV = N0; Op = F.AO + rowq * DM + 512 + h * 64; }
    else { Qp = F.QN + rowq * 1024 + h * 64; Qr = F.QR + rowq * 512 + h * 32; Kb = F.KN + rowb * 1024 + h * 64; KRb = F.KR + rowb * 32; Vb = F.VV + rowb * 1024 + h * 64; pK = pV = 1024; Op = F.AO + rowq * DM + h * 64; }
    int t_first, t_step, NT;
    if (MODE == 0) { t_first = q0 / 64 + 3; t_step = -1; NT = q0 / 64 + 4; }
    else if (MODE == 1) { const int tlo = q0 / 64 - 2 < 0 ? 0 : q0 / 64 - 2; t_first = tlo; t_step = 1; NT = q0 / 64 + 4 - tlo; }
    else { t_first = 0; t_step = 1; NT = q0 / 64 + 4; }
    const bf16* ksrc = Kb + (size_t)lane * pK + wid * 8;
    const bf16* krsrc = MODE == 2 ? KRb + (size_t)lane * 32 + (wid & 3) * 8 : nullptr;
    const bf16* vsrc = Vb + (size_t)(16 * (wid & 3) + (lane >> 2)) * pV + (wid >> 2) * 32 + (lane & 3) * 8;
    const unsigned lds0 = (unsigned)(uintptr_t)lds;
#define ATT_ISSUE(ti, slot) do { const int kb_ = 64 * (ti); const unsigned so_ = (unsigned)(slot); \
        glds16(ksrc + (size_t)kb_ * pK, (unsigned)__builtin_amdgcn_readfirstlane(lds0 + OFF_K + so_ * SLOT_K + wid * 1024)); \
        if (MODE == 2 && wid < 4) glds16(krsrc + (size_t)kb_ * 32, (unsigned)__builtin_amdgcn_readfirstlane(lds0 + OFF_K + so_ * SLOT_K + (8 + wid) * 1024)); \
        glds16(vsrc + (size_t)kb_ * pV, (unsigned)__builtin_amdgcn_readfirstlane(lds0 + OFF_V + so_ * SLOT_V + wid * 1024)); } while (0)
    ATT_ISSUE(t_first, 0);
    if (NT > 1) ATT_ISSUE(t_first + t_step, 1);
    bf16x8 qr[ND2];
#pragma unroll
    for (int c2 = 0; c2 < 4; ++c2) qr[c2] = *(const bf16x8*)(Qp + 16 * c2 + 8 * hi);
    if (MODE == 2) { qr[ND2 - 2] = *(const bf16x8*)(Qr + 8 * hi); qr[ND2 - 1] = *(const bf16x8*)(Qr + 16 + 8 * hi); }
    LAS float* tb = (LAS float*)(lds + OFF_TB);
    volatile LAS unsigned* flg = (volatile LAS unsigned*)(lds + OFF_FLAG);
    if (MODE == 1 && tid < 128) tb[tid] = t5_bias2(F, tid, h);
    f32x16 o[2]; o[0] = f32x16{}; o[1] = f32x16{};
    float m_run = MODE == 1 ? F.sinks[h] * LOG2E : -1e30f, l_run = (MODE == 1 && hi == 0) ? 1.0f : 0.0f, C = 1.0f;
    const LAS unsigned char* kp0 = lds + OFF_K + hi * 1024 + r32 * 16;
    const LAS unsigned char* vp0 = lds + OFF_V + ((lane >> 4) & 1) * 32 + (lane & 3) * 8 + (4 * hi + ((lane & 15) >> 2)) * 64;
    int slot = 0;
    for (int i = 0; i < NT; ++i) {
        if (i == 0 || i + 1 >= NT) ATT_WAIT_BAR(0);
        else if (MODE == 2 && wid < 4) ATT_WAIT_BAR(3);
        else ATT_WAIT_BAR(2);
        if (MODE == 0 && i > 0) { const LAS unsigned* fp = (const LAS unsigned*)(lds + OFF_FLAG) + ((i - 1) & 1) * 8; unsigned a = 1u;
#pragma unroll
            for (int w = 0; w < 8; ++w) a &= fp[w];
            if (__builtin_amdgcn_readfirstlane(a)) break; }
        if (i + 2 < NT) ATT_ISSUE(t_first + (i + 2) * t_step, slot == 0 ? 2 : slot - 1);
        const int kb = 64 * (t_first + i * t_step);
        bool skip, need_mask;
        if (MODE == 0) { skip = kb >= qw0 + 31; need_mask = kb + 63 >= qw0; }
        else if (MODE == 1) { skip = kb > qw0 + 31 || kb + 63 < qw0 - 127; need_mask = true; }
        else { skip = kb > qw0 + 31; need_mask = kb + 63 > qw0; }
        if (!skip) {
            f32x16 s0 = f32x16{}, s1 = f32x16{};
            const LAS unsigned char* kp = kp0 + slot * SLOT_K;
#pragma unroll
            for (int c2 = 0; c2 < ND2; ++c2) {
                const bf16x8 k0 = *(const LAS bf16x8*)(kp + c2 * 2048), k1 = *(const LAS bf16x8*)(kp + c2 * 2048 + 512);
                s0 = __builtin_amdgcn_mfma_f32_32x32x16_bf16(k0, qr[c2], s0, 0, 0, 0);
                s1 = __builtin_amdgcn_mfma_f32_32x32x16_bf16(k1, qr[c2], s1, 0, 0, 0);
            }
            u32x4 pw[4];
            if (MODE == 0) {
                float om[32], be[32];
#pragma unroll
                for (int r = 0; r < 16; ++r) {
                    { const float e = __builtin_amdgcn_exp2f(fminf(s0[r], 64.0f)), d = __builtin_amdgcn_rcpf(1.0f + e); om[r] = d; be[r] = e * d; }
                    { const float e = __builtin_amdgcn_exp2f(fminf(s1[r], 64.0f)), d = __builtin_amdgcn_rcpf(1.0f + e); om[16 + r] = d; be[16 + r] = e * d; }
                }
                if (need_mask) {
#pragma unroll
                    for (int r = 0; r < 16; ++r) { const int key = kb + crow(r, hi);
                        if (key >= qg) { om[r] = 1.0f; be[r] = 0.0f; }
                        if (key + 32 >= qg) { om[16 + r] = 1.0f; be[16 + r] = 0.0f; } }
                }
                float ga[8], gb[8];
#pragma unroll
                for (int gi = 0; gi < 8; ++gi) { const float gp = (om[4 * gi] * om[4 * gi + 1]) * (om[4 * gi + 2] * om[4 * gi + 3]);
                    const auto rr = __builtin_amdgcn_permlane32_swap(__float_as_uint(gp), __float_as_uint(gp), false, false); ga[gi] = __uint_as_float(rr[0]); gb[gi] = __uint_as_float(rr[1]); }
                float R = C, Rm[8];
#pragma unroll
                for (int gi = 7; gi >= 0; --gi) { const float Rb = R; R *= gb[gi]; const float Ra = R; R *= ga[gi]; Rm[gi] = hi ? Rb : Ra; }
                C = R;
#pragma unroll
                for (int gi = 0; gi < 8; ++gi) { float P = Rm[gi];
                    be[4 * gi + 3] *= P; P *= om[4 * gi + 3]; be[4 * gi + 2] *= P; P *= om[4 * gi + 2]; be[4 * gi + 1] *= P; P *= om[4 * gi + 1]; be[4 * gi] *= P; }
#pragma unroll
                for (int k = 0; k < 4; ++k) pw[k] = (u32x4){cvtpk(be[8 * k], be[8 * k + 1]), cvtpk(be[8 * k + 2], be[8 * k + 3]), cvtpk(be[8 * k + 4], be[8 * k + 5]), cvtpk(be[8 * k + 6], be[8 * k + 7])};
            } else {
                if (MODE == 1) {
#pragma unroll
                    for (int r = 0; r < 16; ++r) { const int rel = qg - (kb + crow(r, hi));
                        s0[r] = (rel >= 0 && rel < 128) ? s0[r] + tb[rel & 127] : -INFINITY;
                        s1[r] = (rel - 32 >= 0 && rel - 32 < 128) ? s1[r] + tb[(rel - 32) & 127] : -INFINITY; }
                } else if (need_mask) {
#pragma unroll
                    for (int r = 0; r < 16; ++r) { const int key = kb + crow(r, hi); if (key > qg) s0[r] = -INFINITY; if (key + 32 > qg) s1[r] = -INFINITY; }
                }
                float mx = fmaxf(s0[0], s1[0]);
#pragma unroll
                for (int r = 1; r < 16; ++r) mx = fmaxf(mx, fmaxf(s0[r], s1[r]));
                { const auto rr = __builtin_amdgcn_permlane32_swap(__float_as_uint(mx), __float_as_uint(mx), false, false); mx = fmaxf(__uint_as_float(rr[0]), __uint_as_float(rr[1])); }
                const float mn = fmaxf(m_run, mx);
                if (__any(mn > m_run)) { const float al = __builtin_amdgcn_exp2f(m_run - mn); l_run *= al; m_run = mn;
#pragma unroll
                    for (int r = 0; r < 16; ++r) { o[0][r] *= al; o[1][r] *= al; } }
                float ls = 0.f;
#pragma unroll
                for (int r = 0; r < 16; ++r) { s0[r] = __builtin_amdgcn_exp2f(s0[r] - m_run); s1[r] = __builtin_amdgcn_exp2f(s1[r] - m_run); ls += s0[r] + s1[r]; }
                l_run += ls;
                pw[0] = (u32x4){cvtpk(s0[0], s0[1]), cvtpk(s0[2], s0[3]), cvtpk(s0[4], s0[5]), cvtpk(s0[6], s0[7])};
                pw[1] = (u32x4){cvtpk(s0[8], s0[9]), cvtpk(s0[10], s0[11]), cvtpk(s0[12], s0[13]), cvtpk(s0[14], s0[15])};
                pw[2] = (u32x4){cvtpk(s1[0], s1[1]), cvtpk(s1[2], s1[3]), cvtpk(s1[4], s1[5]), cvtpk(s1[6], s1[7])};
                pw[3] = (u32x4){cvtpk(s1[8], s1[9]), cvtpk(s1[10], s1[11]), cvtpk(s1[12], s1[13]), cvtpk(s1[14], s1[15])};
            }
            const LAS unsigned char* vp = vp0 + slot * SLOT_V;
#pragma unroll
            for (int dh = 0; dh < 2; ++dh)
#pragma unroll
                for (int ks = 0; ks < 4; ++ks) {
                    const v4i16_t lo = __builtin_amdgcn_ds_read_tr16_b64_v4i16((LAS v4i16_t*)(vp + dh * 4096 + ks * 1024));
                    const v4i16_t hi4 = __builtin_amdgcn_ds_read_tr16_b64_v4i16((LAS v4i16_t*)(vp + dh * 4096 + ks * 1024 + 512));
                    const bf16x8 vf = (bf16x8){lo[0], lo[1], lo[2], lo[3], hi4[0], hi4[1], hi4[2], hi4[3]};
                    o[dh] = __builtin_amdgcn_mfma_f32_32x32x16_bf16(vf, __builtin_bit_cast(bf16x8, pw[ks]), o[dh], 0, 0, 0);
                }
        }
        if (MODE == 0) { const unsigned small = __all(C < 1.17549435e-38f) ? 1u : 0u; if (lane == 0) flg[(i & 1) * 8 + wid] = small; }
        slot = slot == 2 ? 0 : slot + 1;
    }
    float sc = 1.0f;
    if (MODE != 0) { const auto rr = __builtin_amdgcn_permlane32_swap(__float_as_uint(l_run), __float_as_uint(l_run), false, false); sc = 1.0f / (__uint_as_float(rr[0]) + __uint_as_float(rr[1])); }
#pragma unroll
    for (int dh = 0; dh < 2; ++dh)
#pragma unroll
        for (int g = 0; g < 4; ++g)
            *(u32x2*)(Op + 32 * dh + 8 * g + 4 * hi) = (u32x2){cvtpk(o[dh][4 * g] * sc, o[dh][4 * g + 1] * sc), cvtpk(o[dh][4 * g + 2] * sc, o[dh][4 * g + 3] * sc)};
    ATT_WAIT_BAR(0);
#undef ATT_ISSUE
}
__device__ __forceinline__ void attn0_phase(const Frame& F, LAS unsigned char* lds) {
    const int vcu = (F.G % 8 == 0) ? (F.bid % 8) * (F.G / 8) + F.bid / 8 : F.bid;
    for (int p = vcu; p < 256; p += F.G) { const int bh = p >> 3, s = p & 7, b = bh >> 3, h = bh & 7;
#if USE_FAST_SB
        for (int k = 0; k < 2; ++k) attn_unit<0>(F, lds, b, h, k ? s : 15 - s);
#endif
#if USE_FAST_SWA
        for (int k = 0; k < 2; ++k) attn_unit<1>(F, lds, b, h, k ? s : 15 - s);
#endif
    }
}
__device__ __forceinline__ void attn1_phase(const Frame& F, LAS unsigned char* lds) {
    const int vcu = (F.G % 8 == 0) ? (F.bid % 8) * (F.G / 8) + F.bid / 8 : F.bid;
    for (int p = vcu; p < 256; p += F.G) { const int bh = p >> 2, s = p & 3, b = bh >> 4, h = bh & 15;
        for (int k = 0; k < 4; ++k) attn_unit<2>(F, lds, b, h, k == 0 ? 15 - s : (k == 1 ? 11 - s : (k == 2 ? 4 + s : s))); }
}
}

#define RLX_AGENT __ATOMIC_RELAXED, __HIP_MEMORY_SCOPE_AGENT
#define XB_TMO      128
#define XB_XCNT(j)  (256  + 64 * (j))
#define XB_XSUB(j)  (1280 + 64 * (j))
#define XB_XGEN(j)  (2304 + 64 * (j))
#define XB_TOP      3328
#define XB_TOPGEN   3392
#define XCD_BAR_WORDS 3456
#define XB_SPIN_CAP (1u << 22)
__device__ __forceinline__ unsigned xb_ld(unsigned* p)              { return __hip_atomic_load(p, __ATOMIC_RELAXED, __HIP_MEMORY_SCOPE_AGENT); }
__device__ __forceinline__ unsigned xb_add(unsigned* p, unsigned v) { return __hip_atomic_fetch_add(p, v, __ATOMIC_RELAXED, __HIP_MEMORY_SCOPE_AGENT); }
__device__ __forceinline__ unsigned xb_xcc_id() { return (unsigned)__builtin_amdgcn_s_getreg((3 << 11) | 20) & 0xFu; }
#define XB_SPIN(cond, bar) do { unsigned _sp = 0; while (cond) { __builtin_amdgcn_s_sleep(1); \
    if ((++_sp & 255u) == 0u) { if (xb_ld(&(bar)[XB_TMO])) break; if (_sp > XB_SPIN_CAP) { atomicAdd(&(bar)[XB_TMO], 1u); break; } } } } while (0)
struct XcdBarrier { unsigned* bar; unsigned x; volatile LAS unsigned* st; };
__device__ __forceinline__ XcdBarrier xcd_barrier_post(unsigned* bar, volatile LAS unsigned* st) {
    XcdBarrier b; b.bar = bar; b.x = xb_xcc_id(); b.st = st;
    if (threadIdx.x == 0) (void)xb_add(&bar[XB_XCNT(b.x)], 1u);
    return b;
}
__device__ __forceinline__ void xcd_barrier_complete(unsigned* bar, unsigned x, unsigned& nloc, unsigned& nx) {
    const unsigned G = gridDim.x * gridDim.y * gridDim.z;
    unsigned sum, cnt, mine, sp = 0u;
    for (;;) {
        sum = 0u; cnt = 0u; mine = 0u;
#pragma unroll
        for (unsigned j = 0; j < 16; ++j) { const unsigned c = xb_ld(&bar[XB_XCNT(j)]); sum += c; cnt += (c > 0u) ? 1u : 0u; mine = (j == x) ? c : mine; }
        if (sum == G) break;
        __builtin_amdgcn_s_sleep(1);
        if ((++sp & 255u) == 0u) { if (xb_ld(&bar[XB_TMO])) break; if (sp > XB_SPIN_CAP) { atomicAdd(&bar[XB_TMO], 1u); break; } }
    }
    nloc = mine > 0u ? mine : 1u; nx = cnt > 0u ? cnt : 1u;
}
__device__ __forceinline__ void xcd_barrier(const XcdBarrier& b) {
    asm volatile("s_waitcnt vmcnt(0)" ::: "memory");
    __syncthreads();
    if (threadIdx.x == 0) {
        unsigned* bar = b.bar;
        __builtin_amdgcn_s_waitcnt(0);
        unsigned nloc = b.st[0], nx = b.st[1];
        if (nloc == 0u) { xcd_barrier_complete(bar, b.x, nloc, nx); b.st[0] = nloc; b.st[1] = nx; }
        const unsigned old = xb_add(&bar[XB_XSUB(b.x)], 1u);
        const unsigned gen = old / nloc;
        if (old + 1u == (gen + 1u) * nloc) {
            __builtin_amdgcn_fence(__ATOMIC_RELEASE, "agent");
            asm volatile("s_waitcnt vmcnt(0)" ::: "memory");
            const unsigned og = xb_add(&bar[XB_TOP], 1u);
            const unsigned tg = og / nx;
            if (og + 1u == (tg + 1u) * nx) xb_add(&bar[XB_TOPGEN], 1u);
            else XB_SPIN(xb_ld(&bar[XB_TOPGEN]) == tg, bar);
            __builtin_amdgcn_fence(__ATOMIC_ACQUIRE, "agent");
            xb_add(&bar[XB_XGEN(b.x)], 1u);
            asm volatile("s_waitcnt vmcnt(0)" ::: "memory");
        } else {
            XB_SPIN(xb_ld(&bar[XB_XGEN(b.x)]) == gen, bar);
            __builtin_amdgcn_fence(__ATOMIC_ACQUIRE, "agent");
            asm volatile("s_waitcnt vmcnt(0)" ::: "memory");
        }
    }
    __syncthreads();
}
constexpr int RING_BYTES = 131072, LDSCTL_OFF = RING_BYTES, MISC_OFF = LDSCTL_OFF + 320;
constexpr int LDS_BYTES = 147456;
constexpr int CW_BAR = 4096;

constexpr int N_PHASES = 14;
__device__ __forceinline__ GemmDesc gemm_desc(const Frame& F, int ph) {
    GemmDesc g; float* ST = F.ST; const size_t S1 = (size_t)M * 16;
    g.A = F.XN; g.Bt = F.W_IN; g.N = DM; g.K = DM; g.kind = G_RESID; g.rmode = 0; g.stat = ST; g.nslots = 16; g.inv_dim = 1.0f / DM;
    g.base = F.out; g.xout = F.out; g.xn = F.XN; g.stat_out = ST; g.hout = F.H;
    if (ph == 1) { g.Bt = F.W_IN; g.N = N0; g.kind = G_ROWSCALE; g.rmode = R_QKV0; }
    else if (ph == 3) { g.A = F.AO; g.Bt = F.W_OUT; g.base = F.x; g.stat_out = ST + S1; }
    else if (ph == 4) { g.Bt = F.W_GU0; g.N = NGU; g.kind = G_SWIGLU; g.stat = ST + S1; }
    else if (ph == 5) { g.A = F.H; g.Bt = F.W_DN0; g.K = FFH; g.stat_out = ST + 2 * S1; }
    else if (ph == 6) { g.Bt = F.W_MD; g.N = NMD; g.kind = G_ROWSCALE; g.rmode = R_MD; g.stat = ST + 2 * S1; }
    else if (ph == 7) { g.A = F.CQ; g.Bt = F.W_UQ; g.N = NUQ; g.K = QRANK; g.kind = G_ROWSCALE; g.rmode = R_UQ; g.stat = F.SQ; g.nslots = 12; g.inv_dim = 1.0f / QRANK; }
    else if (ph == 8) { g.A = F.CKV; g.Bt = F.W_UKV; g.N = NUKV; g.K = KVRANK; g.kind = G_ROWSCALE; g.rmode = R_UKV; g.stat = F.SKV; g.nslots = 8; g.inv_dim = 1.0f / KVRANK; }
    else if (ph == 10) { g.A = F.AO; g.Bt = F.W_O; g.stat_out = ST + 3 * S1; }
    else if (ph == 11) { g.Bt = F.W_GU1; g.N = NGU; g.kind = G_SWIGLU; g.stat = ST + 3 * S1; }
    else { g.A = F.H; g.Bt = F.W_DN1; g.K = FFH; g.xn = nullptr; g.stat_out = ST + 4 * S1; }
    return g;
}

struct Args { const void* in[18]; float* out; unsigned char* ws; int ph_lo, ph_hi; };
__global__ void __launch_bounds__(NTHR, 2) mk_fwd(Args a) {
    extern __shared__ __attribute__((aligned(16))) unsigned char lds_raw[];
    LAS unsigned char* lds = (LAS unsigned char*)lds_raw;
    Frame F;
    F.tid = threadIdx.x; F.lane = F.tid & 63; F.wave = __builtin_amdgcn_readfirstlane(F.tid >> 6); F.G = gridDim.x; F.bid = blockIdx.x;
    F.x = (const float*)a.in[0]; F.pos = (const int*)a.in[1]; F.attn_norm = (const float*)a.in[2]; F.ffn_norm = (const float*)a.in[3]; F.w_in = (const float*)a.in[4]; F.sinks = (const float*)a.in[5];
    F.w_out = (const float*)a.in[6]; F.relb = (const float*)a.in[7]; F.w_md = (const float*)a.in[8]; F.q_norm = (const float*)a.in[9]; F.w_uq = (const float*)a.in[10]; F.kv_norm = (const float*)a.in[11];
    F.w_ukv = (const float*)a.in[12]; F.w_o = (const float*)a.in[13]; F.w_gate = (const float*)a.in[14]; F.w_up = (const float*)a.in[15]; F.w_down = (const float*)a.in[16]; F.final_norm = (const float*)a.in[17];
    F.out = a.out; F.ws = a.ws; unsigned char* ws = a.ws;
    F.W_IN = (bf16*)(ws + WS_W_IN); F.W_OUT = (bf16*)(ws + WS_W_OUT); F.W_GU0 = (bf16*)(ws + WS_W_GU0); F.W_DN0 = (bf16*)(ws + WS_W_DN0); F.W_MD = (bf16*)(ws + WS_W_MD);
    F.W_UQ = (bf16*)(ws + WS_W_UQ); F.W_UKV = (bf16*)(ws + WS_W_UKV); F.W_O = (bf16*)(ws + WS_W_O); F.W_GU1 = (bf16*)(ws + WS_W_GU1); F.W_DN1 = (bf16*)(ws + WS_W_DN1);
    F.ST = (float*)(ws + WS_ST); F.SQ = (float*)(ws + WS_SQ); F.SKV = (float*)(ws + WS_SKV); F.CS = (f32x2*)(ws + WS_CS);
    F.XN = (bf16*)(ws + WS_XN); F.AO = (bf16*)(ws + WS_AO); F.QKV0 = (bf16*)(ws + WS_QKV0); F.H = (bf16*)(ws + WS_H); F.CQ = (bf16*)(ws + WS_CQ); F.CKV = (bf16*)(ws + WS_CKV);
    F.KR = (bf16*)(ws + WS_KR); F.QN = (bf16*)(ws + WS_QN); F.QR = (bf16*)(ws + WS_QR); F.KN = (bf16*)(ws + WS_KN); F.VV = (bf16*)(ws + WS_VV);

    for (int u = F.tid; u < (LDS_BYTES - LDSCTL_OFF) / 4; u += NTHR) ((LAS unsigned*)(lds + LDSCTL_OFF))[u] = 0u;
    __syncthreads();
    XcdBarrier bar; bar.bar = (unsigned*)(ws + WS_CTL) + CW_BAR; bar.x = 0; bar.st = nullptr;
    if (a.ph_hi - a.ph_lo > 1) bar = xcd_barrier_post((unsigned*)(ws + WS_CTL) + CW_BAR, (volatile LAS unsigned*)(lds + MISC_OFF) + 8);
    for (int ph = a.ph_lo; ph < a.ph_hi; ++ph) {
        { int t_; asm volatile("v_mov_b32 %0, %1" : "=v"(t_) : "v"(threadIdx.x)); F.tid = t_; F.lane = t_ & 63; }
        if (ph == 0) p0_prologue(F, lds);
        else if (ph == 2) {
#if !USE_FAST_SB
            naive_sb(F);
#endif
#if !USE_FAST_SWA
            naive_swa(F);
#endif
#if USE_FAST_SB || USE_FAST_SWA
            att::attn0_phase(F, lds);
#endif
        }
        else if (ph == 9) {
#if USE_FAST_MLA
            att::attn1_phase(F, lds);
#else
            naive_mla(F);
#endif
        }
        else if (ph == 13) final_norm_phase(F);
        else {
            const GemmDesc g = gemm_desc(F, ph);
#if USE_FAST_GEMM
            const pg8::Gemm pg{g.A, g.Bt, M, g.N, g.K}; pg8::StaticOrder S; S.init(M, g.N, F.G, F.bid);
            if (g.kind == G_ROWSCALE) { const pg8::EpiRowScale E{&F, g.rmode, g.stat, g.nslots, g.inv_dim}; pg8::gemm_phase<pg8::EpiRowScale, pg8::StaticOrder, true, true>(lds, pg, S, E); }
            else if (g.kind == G_SWIGLU) { const pg8::EpiSwiGLU E{g.hout, g.stat, g.nslots, g.inv_dim}; pg8::gemm_phase<pg8::EpiSwiGLU, pg8::StaticOrder, true, true>(lds, pg, S, E); }
            else { const pg8::EpiResid E{g.base, g.xout, g.xn, g.stat_out}; pg8::gemm_phase<pg8::EpiResid, pg8::StaticOrder, true, true>(lds, pg, S, E); }
#else
            naive_gemm_phase(F, g);
#endif
        }
        if (ph + 1 < a.ph_hi && ph != 7) xcd_barrier(bar);
    }
}

extern "C" void kernel_launch(void* const* d_in, const int* in_sizes, int n_in, void* d_out, int out_size, void* d_ws, size_t ws_size, hipStream_t stream) {
    static int grid = 0;
    if (grid == 0) {
        if (n_in != 18 || in_sizes[0] != M * DM || out_size != M * DM || ws_size < WS_END) { fprintf(stderr, "kernel_launch: unexpected problem shape / workspace (n_in %d, ws %zu)\n", n_in, ws_size); grid = -1; return; }
        int dev = 0, cus = 0;
        if (hipGetDevice(&dev) != hipSuccess || hipDeviceGetAttribute(&cus, hipDeviceAttributeMultiprocessorCount, dev) != hipSuccess) { grid = -1; return; }
        if (hipFuncSetAttribute((const void*)mk_fwd, hipFuncAttributeMaxDynamicSharedMemorySize, LDS_BYTES) != hipSuccess) { fprintf(stderr, "kernel_launch: hipFuncSetAttribute failed\n"); grid = -1; return; }
        grid = cus;
    }
    if (grid < 0) return;
    Args a{};
    for (int i = 0; i < 18; ++i) a.in[i] = d_in[i];
    a.out = (float*)d_out; a.ws = (unsigned char*)d_ws;
#if MK_ONE_LAUNCH
    if (hipMemsetAsync((char*)d_ws + WS_CTL, 0, 65536, stream) != hipSuccess) { fprintf(stderr, "kernel_launch: memset failed\n"); return; }
    a.ph_lo = 0; a.ph_hi = N_PHASES;
    void* kargs[] = {&a};
    const hipError_t e = hipLaunchCooperativeKernel((const void*)mk_fwd, dim3(grid), dim3(NTHR), kargs, LDS_BYTES, stream);
    if (e != hipSuccess) fprintf(stderr, "kernel_launch: cooperative launch failed: %s (grid %d)\n", hipGetErrorString(e), grid);
#else
    for (int ph = 0; ph < N_PHASES; ++ph) {
        a.ph_lo = ph; a.ph_hi = ph + 1;
        hipLaunchKernelGGL(mk_fwd, dim3(grid), dim3(NTHR), LDS_BYTES, stream, a);
    }
#endif
}
```

```cpp
#include <hip/hip_runtime.h>
#include <cstdio>
#include <cstdint>

#ifndef MK_ONE_LAUNCH
#define MK_ONE_LAUNCH 1
#endif
#ifndef PROBE_MASK
#define PROBE_MASK 0
#endif
#ifndef USE_FAST_GEMM
#define USE_FAST_GEMM 1
#endif
#ifndef USE_FAST_SB
#define USE_FAST_SB 1
#endif
#ifndef USE_FAST_SWA
#define USE_FAST_SWA 1
#endif
#ifndef USE_FAST_MLA
#define USE_FAST_MLA 1
#endif

#define GAS __attribute__((address_space(1)))
#define LAS __attribute__((address_space(3)))
typedef unsigned short bf16;
typedef short bf16x8 __attribute__((ext_vector_type(8)));
typedef float f32x4 __attribute__((ext_vector_type(4)));
typedef float f32x2 __attribute__((ext_vector_type(2)));
typedef unsigned u32x4 __attribute__((ext_vector_type(4)));
typedef unsigned u32x2 __attribute__((ext_vector_type(2)));

constexpr int BATCH = 4, SEQ = 4096, DM = 1024, M = BATCH * SEQ;
constexpr int N0 = 2304, FFH = 2816, NGU = 2 * FFH, NMD = 768, QRANK = 384, KVRANK = 256, NUQ = 1536, NUKV = 2048;
constexpr float EPS = 1e-6f;
constexpr float LOG2E = 1.4426950408889634f;
constexpr int NWAVES = 8, NTHR = 512;

constexpr size_t MiB = 1u << 20;
constexpr size_t WS_CTL = 0, CTL_ZERO_BYTES = 1 * MiB;
constexpr size_t WS_W_IN = 1 * MiB;
constexpr size_t WS_W_OUT = WS_W_IN + (size_t)N0 * DM * 2;
constexpr size_t WS_W_GU0 = WS_W_OUT + (size_t)DM * DM * 2;
constexpr size_t WS_W_DN0 = WS_W_GU0 + (size_t)NGU * DM * 2;
constexpr size_t WS_W_MD = WS_W_DN0 + (size_t)DM * FFH * 2;
constexpr size_t WS_W_UQ = WS_W_MD + (size_t)NMD * DM * 2;
constexpr size_t WS_W_UKV = WS_W_UQ + (size_t)NUQ * QRANK * 2;
constexpr size_t WS_W_O = WS_W_UKV + (size_t)NUKV * KVRANK * 2;
constexpr size_t WS_W_GU1 = WS_W_O + (size_t)DM * DM * 2;
constexpr size_t WS_W_DN1 = WS_W_GU1 + (size_t)NGU * DM * 2;
constexpr size_t WS_W_END = WS_W_DN1 + (size_t)DM * FFH * 2;
static_assert(WS_W_END <= 47 * MiB, "weights");
constexpr size_t WS_ST = 47 * MiB;
constexpr size_t WS_SQ = 52 * MiB, WS_SKV = 53 * MiB;
constexpr size_t WS_CS = 54 * MiB;
constexpr size_t WS_XN = 56 * MiB;
constexpr size_t WS_AO = 88 * MiB;
constexpr size_t WS_BIG = 120 * MiB;
constexpr size_t WS_QKV0 = WS_BIG;
constexpr size_t WS_H = WS_BIG;
constexpr size_t WS_CQ = WS_BIG;
constexpr size_t WS_CKV = WS_BIG + 12 * MiB;
constexpr size_t WS_KR = WS_BIG + 20 * MiB;
constexpr size_t WS_QN = WS_BIG + 21 * MiB;
constexpr size_t WS_QR = WS_BIG + 53 * MiB;
constexpr size_t WS_KN = WS_BIG + 69 * MiB;
constexpr size_t WS_VV = WS_BIG + 101 * MiB;
constexpr size_t WS_END = WS_BIG + 133 * MiB;
static_assert(WS_END <= 256 * MiB, "d_ws map");

__device__ __forceinline__ unsigned f2bf(float f) { unsigned u = __builtin_bit_cast(unsigned, f); return (u + 0x7fffu + ((u >> 16) & 1u)) >> 16; }
__device__ __forceinline__ unsigned pk2(float lo, float hi) { return f2bf(lo) | (f2bf(hi) << 16); }
typedef __bf16 bf16x2_g __attribute__((ext_vector_type(2)));
__device__ __forceinline__ unsigned cvtpk_g(float lo, float hi) { f32x2 v = {lo, hi}; bf16x2_g b = __builtin_convertvector(v, bf16x2_g); return __builtin_bit_cast(unsigned, b); }
__device__ __forceinline__ float bf2f(unsigned short b) { return __builtin_bit_cast(float, (unsigned)b << 16); }
__device__ __forceinline__ float wave_sum(float v) {
#pragma unroll
    for (int o = 1; o < 64; o <<= 1) v += __shfl_xor(v, o);
    return v;
}

struct Frame {
    int tid, lane, wave, G, bid;
    const float* x; const int* pos; const float* attn_norm; const float* ffn_norm; const float* w_in; const float* sinks; const float* w_out; const float* relb;
    const float* w_md; const float* q_norm; const float* w_uq; const float* kv_norm; const float* w_ukv; const float* w_o; const float* w_gate; const float* w_up; const float* w_down; const float* final_norm;
    float* out; unsigned char* ws;
    bf16 *W_IN, *W_OUT, *W_GU0, *W_DN0, *W_MD, *W_UQ, *W_UKV, *W_O, *W_GU1, *W_DN1;
    float *ST, *SQ, *SKV; f32x2* CS;
    bf16 *XN, *AO, *QKV0, *H, *CQ, *CKV, *KR, *QN, *QR, *KN, *VV;
};

__device__ __forceinline__ float row_rstd(const float* st, int row, int nslots, float inv_dim) {
    const f32x4* p = (const f32x4*)(st + (size_t)row * 16); float s = 0.f;
#pragma unroll
    for (int i = 0; i < 4; ++i) if (4 * i < nslots) { const f32x4 v = p[i]; s += (v.x + v.y) + (v.z + v.w); }
    return 1.0f / sqrtf(s * inv_dim + EPS);
}

enum { R_QKV0 = 0, R_MD = 1, R_UQ = 2, R_UKV = 3 };
struct Route { bf16* dst; int pitch; int col; int rope; int wc0only; float* stat; int slot; };
__device__ __forceinline__ Route route(const Frame& F, int mode, int hh) {
    Route r; r.rope = 0; r.wc0only = 0; r.slot = 0; size_t off, soff = 0; int st = 0;
    if (mode == R_QKV0) { off = WS_QKV0; r.pitch = N0; r.col = hh * 128; }
    else if (mode == R_MD) {
        if (hh < 3) { off = WS_CQ; r.pitch = QRANK; r.col = hh * 128; st = 1; soff = WS_SQ; r.slot = hh * 4; }
        else if (hh == 3) { off = WS_KR; r.pitch = 32; r.col = 0; r.rope = 1; r.wc0only = 1; }
        else { off = WS_CKV; r.pitch = KVRANK; r.col = (hh - 4) * 128; st = 1; soff = WS_SKV; r.slot = (hh - 4) * 4; }
    } else if (mode == R_UQ) {
        if (hh < 8) { off = WS_QN; r.pitch = 1024; r.col = hh * 128; }
        else { off = WS_QR; r.pitch = 512; r.col = (hh - 8) * 128; r.rope = 1; }
    } else {
        if (hh < 8) { off = WS_KN; r.pitch = 1024; r.col = hh * 128; }
        else { off = WS_VV; r.pitch = 1024; r.col = (hh - 8) * 128; }
    }
    r.dst = (bf16*)(F.ws + off); r.stat = st ? (float*)(F.ws + soff) : nullptr;
    return r;
}

namespace pg8 {
#define PG8_LAS __attribute__((address_space(3)))
typedef unsigned short bf16_t;
typedef short bf16x8 __attribute__((ext_vector_type(8)));
typedef float f32x4 __attribute__((ext_vector_type(4)));
typedef unsigned u32x4 __attribute__((ext_vector_type(4)));
constexpr int BM = 256, BK = 64, HALF = 128, HTB = HALF * BK * 2  , STAGE_BYTES = 8 * HTB, NXCD = 8, WGM = 8;

__host__ __device__ __forceinline__ int lds_byte(int r, int c) { const int st = (r >> 4) * 2 + (c >> 5), rr = r & 15, cc = c & 31, ob = rr * 64 + cc * 2; return st * 1024 + (ob ^ (((ob >> 9) & 1) << 5)); }
__host__ __device__ __forceinline__ void stage_rc(int b, int& R, int& C) { const int st = b / 1024, sb = b % 1024, swz = sb ^ (((sb >> 9) & 1) << 5); R = (st >> 1) * 16 + swz / 64; C = (st & 1) * 32 + (swz % 64) / 2; }
__host__ __device__ __forceinline__ int perm32(int rho) { const int n = rho >> 4, i = rho & 15; return 8 * (i >> 2) + 4 * n + (i & 3); }

struct Unit { int pm, pn; };
struct Gemm { const bf16_t* A; const bf16_t* Bt; int M, N, K; };

struct StaticOrder {
    int nM, nN, nwg, G, c;
    __host__ __device__ void init(int M, int N, int G_, int c_) { nM = M / BM; nN = N / BM; nwg = nM * nN; G = G_; c = c_; }
    __host__ __device__ bool next(int i, Unit& u) const {
        const long L = (long)i * G + c; if (L >= nwg) return false;
        int wgid = (int)L; { const int q = nwg / NXCD, r = nwg % NXCD, xcd = wgid % NXCD, off = wgid / NXCD; wgid = (xcd < r ? xcd * (q + 1) : r * (q + 1) + (xcd - r) * q) + off; }
        const int nig = WGM * nN, gid = wgid / nig, fm = gid * WGM, gsz = (nM - fm) < WGM ? (nM - fm) : WGM;
        u.pm = fm + ((wgid % nig) % gsz); u.pn = (wgid % nig) / gsz; return true;
    }
    __device__ __forceinline__ void a_ready(const Unit&) const {}
    __device__ __forceinline__ void done(const Unit&) const {}
};

typedef __bf16 bf16x2_t __attribute__((ext_vector_type(2)));
typedef float f32x2v __attribute__((ext_vector_type(2)));
__device__ __forceinline__ unsigned cvtpk(float lo, float hi) { f32x2v v = {lo, hi}; bf16x2_t b = __builtin_convertvector(v, bf16x2_t); return __builtin_bit_cast(unsigned, b); }

struct EpiRowScale {
    static constexpr bool PERM = true, AFTER_DRAIN = false;
    const ::Frame* F; int rmode; const float* stat; int nslots; float inv_dim;
    __device__ __forceinline__ void operator()(const f32x4 (&acc)[2][2][4][2], const Unit& u, int wr, int wc, int fr, int fq) const {
        const int row0 = u.pm * BM + wr * 64 + fr;
        float rs[2][4];
#pragma unroll
        for (int ai = 0; ai < 2; ++ai)
#pragma unroll
            for (int m = 0; m < 4; ++m) rs[ai][m] = ::row_rstd(stat, row0 + ai * HALF + m * 16, nslots, inv_dim);
#pragma unroll
        for (int bj = 0; bj < 2; ++bj) {
            const ::Route rt = ::route(*F, rmode, u.pn * 2 + bj);
            if (rt.wc0only && wc != 0) continue;
#pragma unroll
            for (int ai = 0; ai < 2; ++ai)
#pragma unroll
                for (int m = 0; m < 4; ++m) {
                    const int row = row0 + ai * HALF + m * 16;
                    f32x4 v0 = acc[ai][bj][m][0] * rs[ai][m], v1 = acc[ai][bj][m][1] * rs[ai][m];
                    if (rt.stat) {
                        float ss = (v0[0] * v0[0] + v0[1] * v0[1]) + (v0[2] * v0[2] + v0[3] * v0[3]) + (v1[0] * v1[0] + v1[1] * v1[1]) + (v1[2] * v1[2] + v1[3] * v1[3]);
                        ss += __shfl_xor(ss, 16); ss += __shfl_xor(ss, 32);
                        if (fq == 0) rt.stat[(size_t)row * 16 + rt.slot + wc] = ss;
                    }
                    if (rt.rope) {
                        const f32x4* csp = (const f32x4*)(F->CS + (size_t)row * 16 + 8 * (fq & 1));
                        const f32x4 c0 = csp[0], c1 = csp[1], c2 = csp[2], c3 = csp[3];
                        f32x4 p0, p1;
#pragma unroll
                        for (int j = 0; j < 4; ++j) { p0[j] = __shfl_xor(v0[j], 32); p1[j] = __shfl_xor(v1[j], 32); }
                        const float sg = fq < 2 ? -1.0f : 1.0f;
                        v0[0] = v0[0] * c0[0] + sg * p0[0] * c0[1]; v0[1] = v0[1] * c0[2] + sg * p0[1] * c0[3]; v0[2] = v0[2] * c1[0] + sg * p0[2] * c1[1]; v0[3] = v0[3] * c1[2] + sg * p0[3] * c1[3];
                        v1[0] = v1[0] * c2[0] + sg * p1[0] * c2[1]; v1[1] = v1[1] * c2[2] + sg * p1[1] * c2[3]; v1[2] = v1[2] * c3[0] + sg * p1[2] * c3[1]; v1[3] = v1[3] * c3[2] + sg * p1[3] * c3[3];
                    }
                    u32x4 w; w.x = cvtpk(v0[0], v0[1]); w.y = cvtpk(v0[2], v0[3]); w.z = cvtpk(v1[0], v1[1]); w.w = cvtpk(v1[2], v1[3]);
                    *(u32x4*)(rt.dst + (size_t)row * rt.pitch + rt.col + wc * 32 + 8 * fq) = w;
                }
        }
    }
};
struct EpiSwiGLU {
    static constexpr bool PERM = true, AFTER_DRAIN = false;
    bf16_t* H; const float* stat; int nslots; float inv_dim;
    __device__ __forceinline__ void operator()(const f32x4 (&acc)[2][2][4][2], const Unit& u, int wr, int wc, int fr, int fq) const {
        const int row0 = u.pm * BM + wr * 64 + fr, col0 = u.pn * 128 + wc * 32 + 8 * fq;
#pragma unroll
        for (int ai = 0; ai < 2; ++ai)
#pragma unroll
            for (int m = 0; m < 4; ++m) {
                const int row = row0 + ai * HALF + m * 16; const float rs = ::row_rstd(stat, row, nslots, inv_dim);
                float hv[8];
#pragma unroll
                for (int n = 0; n < 2; ++n)
#pragma unroll
                    for (int j = 0; j < 4; ++j) { const float g = acc[ai][0][m][n][j] * rs, up = acc[ai][1][m][n][j] * rs;
                        hv[4 * n + j] = g * up * __builtin_amdgcn_rcpf(1.0f + __builtin_amdgcn_exp2f(-g * ::LOG2E)); }
                u32x4 w; w.x = cvtpk(hv[0], hv[1]); w.y = cvtpk(hv[2], hv[3]); w.z = cvtpk(hv[4], hv[5]); w.w = cvtpk(hv[6], hv[7]);
                *(u32x4*)(H + (size_t)row * ::FFH + col0) = w;
            }
    }
};
struct EpiResid {
    static constexpr bool PERM = false, AFTER_DRAIN = false;
    const float* base; float* xout; bf16_t* xn; float* stat_out;
    __device__ __forceinline__ void operator()(const f32x4 (&acc)[2][2][4][2], const Unit& u, int wr, int wc, int fr, int fq) const {
        const int row0 = u.pm * BM + wr * 64 + fr, col0 = u.pn * BM + wc * 32 + 4 * fq;
#pragma unroll
        for (int ai = 0; ai < 2; ++ai)
#pragma unroll
            for (int m = 0; m < 4; ++m) {
                const int row = row0 + ai * HALF + m * 16; const size_t ro = (size_t)row * ::DM + col0; float ss = 0.f;
#pragma unroll
                for (int bj = 0; bj < 2; ++bj)
#pragma unroll
                    for (int n = 0; n < 2; ++n) { const size_t o = ro + bj * HALF + n * 16; const f32x4 v = *(const f32x4*)(base + o) + acc[ai][bj][m][n];
                        *(f32x4*)(xout + o) = v; ss += (v[0] * v[0] + v[1] * v[1]) + (v[2] * v[2] + v[3] * v[3]);
                        if (xn) { typedef unsigned u32x2v __attribute__((ext_vector_type(2))); *(u32x2v*)(xn + o) = (u32x2v){cvtpk(v[0], v[1]), cvtpk(v[2], v[3])}; } }
                ss += __shfl_xor(ss, 16); ss += __shfl_xor(ss, 32);
                if (fq == 0) stat_out[(size_t)row * 16 + u.pn * 4 + wc] = ss;
            }
    }
};

template <class Epi, class Sched, bool ALIGN_EPI = false, bool SP2 = false>
__device__ __forceinline__ void gemm_phase(PG8_LAS unsigned char* lds, const Gemm g, const Sched& S, const Epi& E) {
    int tid; asm volatile("v_mov_b32 %0, %1" : "=v"(tid) : "v"(threadIdx.x));
    const int wid = __builtin_amdgcn_readfirstlane(tid >> 6), lane = tid & 63, wr = wid >> 2, wc = wid & 3, fr = lane & 15, fq = lane >> 4;
    const int K = g.K, nt = K / BK;
    unsigned voffA[2], voffB[2];
#pragma unroll
    for (int i = 0; i < 2; ++i) { int R, C; stage_rc(tid * 16 + i * 8192, R, C); const int Rb = Epi::PERM ? ((R & ~31) + perm32(R & 31)) : R;
        voffA[i] = (unsigned)(R * K + C) * 2u; voffB[i] = (unsigned)(Rb * K + C) * 2u; }
    const size_t kstep = (size_t)(BK * 2);
    const size_t hstep = (size_t)HALF * K * 2;
    const size_t tstep = 2 * hstep;
    const unsigned ldsw = (unsigned)wid * 1024u;
    const int aoff = lds_byte(wr * 64 + fr, fq * 8), boff = lds_byte(wc * 32 + fr, fq * 8);
#define PG8_SA(b, h) (((b) * 2 + (h)) * HTB)
#define PG8_SB(b, h) ((4 + (b) * 2 + (h)) * HTB)
#define PG8_STAGE(bufoff, gbase, voff) do { _Pragma("unroll") for (int _i = 0; _i < 2; ++_i) \
        __builtin_amdgcn_global_load_lds((const unsigned*)((const char*)(gbase) + (voff)[_i]), (PG8_LAS unsigned*)(lds + (bufoff) + ldsw + _i * 8192), 16, 0, 0); } while (0)
#define PG8_LDA(dst, b, h) do { _Pragma("unroll") for (int m = 0; m < 4; ++m) _Pragma("unroll") for (int k = 0; k < 2; ++k) dst[m][k] = *(const PG8_LAS bf16x8*)(lds + PG8_SA(b, h) + aoff + m * 2048 + k * 1024); } while (0)
#define PG8_LDB(dst, b, h) do { _Pragma("unroll") for (int n = 0; n < 2; ++n) _Pragma("unroll") for (int k = 0; k < 2; ++k) dst[n][k] = *(const PG8_LAS bf16x8*)(lds + PG8_SB(b, h) + boff + n * 2048 + k * 1024); } while (0)
#define PG8_MMA(ai, bj, At, Bt) do { __builtin_amdgcn_s_setprio(1); _Pragma("unroll") for (int m = 0; m < 4; ++m) _Pragma("unroll") for (int n = 0; n < 2; ++n) _Pragma("unroll") for (int k = 0; k < 2; ++k) \
        acc[ai][bj][m][n] = __builtin_amdgcn_mfma_f32_16x16x32_bf16(Bt[n][k], At[m][k], acc[ai][bj][m][n], 0, 0, 0); __builtin_amdgcn_s_setprio(0); } while (0)
#define PG8_WAIT_V(n) asm volatile("s_waitcnt vmcnt(" #n ")" ::: "memory")
#define PG8_WAIT_L(n) asm volatile("s_waitcnt lgkmcnt(" #n ")" ::: "memory")
#define PG8_BAR __builtin_amdgcn_s_barrier()
#define PG8_SCHED __builtin_amdgcn_sched_barrier(0)
    Unit cur, nxt; int ui = 0;
    if (!S.next(0, cur)) return;
    f32x4 acc[2][2][4][2];
#pragma unroll
    for (int a = 0; a < 2; ++a)
#pragma unroll
        for (int b = 0; b < 2; ++b)
#pragma unroll
            for (int m = 0; m < 4; ++m)
#pragma unroll
                for (int n = 0; n < 2; ++n) acc[a][b][m][n] = (f32x4){0.f, 0.f, 0.f, 0.f};
    bf16x8 At[4][2], B0[2][2], B1[2][2];
    const char* cA = (const char*)g.A + (size_t)cur.pm * tstep; const char* cB = (const char*)g.Bt + (size_t)cur.pn * tstep;
    S.a_ready(cur);
    if constexpr (SP2) {
        PG8_STAGE(PG8_SB(0, 0), cB, voffB); PG8_STAGE(PG8_SB(0, 1), cB + hstep, voffB); PG8_STAGE(PG8_SA(0, 0), cA, voffA); PG8_STAGE(PG8_SA(0, 1), cA + hstep, voffA);
        if (wr == 1) PG8_BAR;
        PG8_WAIT_V(2); PG8_BAR;
        PG8_STAGE(PG8_SB(1, 0), cB + kstep, voffB); PG8_STAGE(PG8_SA(1, 0), cA + kstep, voffA); PG8_STAGE(PG8_SB(1, 1), cB + hstep + kstep, voffB);
        PG8_WAIT_V(6); PG8_BAR;
    } else {
        PG8_STAGE(PG8_SB(0, 0), cB, voffB); PG8_STAGE(PG8_SA(0, 0), cA, voffA); PG8_STAGE(PG8_SB(0, 1), cB + hstep, voffB); PG8_STAGE(PG8_SA(0, 1), cA + hstep, voffA);
        if (wr == 1) PG8_BAR;
        PG8_WAIT_V(4); PG8_BAR;
        PG8_STAGE(PG8_SB(1, 0), cB + kstep, voffB); PG8_STAGE(PG8_SA(1, 0), cA + kstep, voffA); PG8_STAGE(PG8_SB(1, 1), cB + hstep + kstep, voffB);
        PG8_WAIT_V(6); PG8_BAR;
    }
    for (;;) {
        const bool has_next = S.next(ui + 1, nxt);
        const char* nA = has_next ? (const char*)g.A + (size_t)nxt.pm * tstep : cA; const char* nB = has_next ? (const char*)g.Bt + (size_t)nxt.pn * tstep : cB;
        for (int t = 0; t < nt; t += 2) {
            const bool last = (t == nt - 2);
            const char* a1 = cA + (size_t)(t + 1) * kstep;
            const char* a2 = last ? nA : cA + (size_t)(t + 2) * kstep; const char* b2 = last ? nB : cB + (size_t)(t + 2) * kstep;
            const char* a3 = a2 + kstep; const char* b3 = b2 + kstep;
            if (last && has_next) S.a_ready(nxt);
            if constexpr (SP2) {
            PG8_LDB(B0, 0, 0); PG8_LDB(B1, 0, 1); PG8_SCHED; PG8_LDA(At, 0, 0); PG8_STAGE(PG8_SA(1, 1), a1 + hstep, voffA);
            PG8_WAIT_V(8); PG8_WAIT_L(0); PG8_BAR; PG8_MMA(0, 0, At, B0); PG8_MMA(0, 1, At, B1); PG8_BAR; PG8_SCHED;
            PG8_LDA(At, 0, 1); PG8_STAGE(PG8_SB(0, 0), b2, voffB); PG8_STAGE(PG8_SB(0, 1), b2 + hstep, voffB); PG8_STAGE(PG8_SA(0, 0), a2, voffA);
            PG8_WAIT_V(8); PG8_WAIT_L(0); PG8_BAR; PG8_MMA(1, 0, At, B0); PG8_MMA(1, 1, At, B1); PG8_BAR; PG8_SCHED;
            PG8_LDB(B0, 1, 0); PG8_LDB(B1, 1, 1); PG8_SCHED; PG8_LDA(At, 1, 0); PG8_STAGE(PG8_SA(0, 1), a2 + hstep, voffA);
            PG8_WAIT_V(8); PG8_WAIT_L(0); PG8_BAR; PG8_MMA(0, 0, At, B0); PG8_MMA(0, 1, At, B1); PG8_BAR; PG8_SCHED;
            PG8_LDA(At, 1, 1); PG8_STAGE(PG8_SB(1, 0), b3, voffB); PG8_STAGE(PG8_SB(1, 1), b3 + hstep, voffB); PG8_STAGE(PG8_SA(1, 0), a3, voffA);
            PG8_WAIT_V(8); PG8_WAIT_L(0); PG8_BAR; PG8_MMA(1, 0, At, B0); PG8_MMA(1, 1, At, B1); PG8_BAR; PG8_SCHED;
            } else {
            PG8_LDB(B0, 0, 0); PG8_SCHED; PG8_LDA(At, 0, 0); PG8_STAGE(PG8_SA(1, 1), a1 + hstep, voffA);
            PG8_WAIT_L(8); PG8_BAR; PG8_WAIT_L(0); PG8_MMA(0, 0, At, B0); PG8_BAR; PG8_SCHED;
            PG8_LDB(B1, 0, 1); PG8_STAGE(PG8_SB(0, 0), b2, voffB);
            PG8_BAR; PG8_WAIT_L(0); PG8_MMA(0, 1, At, B1); PG8_BAR;
            PG8_LDA(At, 0, 1); PG8_STAGE(PG8_SA(0, 0), a2, voffA);
            PG8_BAR; PG8_WAIT_L(0); PG8_MMA(1, 0, At, B0); PG8_BAR; PG8_SCHED;
            PG8_STAGE(PG8_SB(0, 1), b2 + hstep, voffB);
            PG8_WAIT_V(6); PG8_BAR; PG8_MMA(1, 1, At, B1); PG8_BAR;
            PG8_LDB(B0, 1, 0); PG8_SCHED; PG8_LDA(At, 1, 0); PG8_STAGE(PG8_SA(0, 1), a2 + hstep, voffA);
            PG8_WAIT_L(8); PG8_BAR; PG8_WAIT_L(0); PG8_MMA(0, 0, At, B0); PG8_BAR; PG8_SCHED;
            PG8_LDB(B1, 1, 1); PG8_STAGE(PG8_SB(1, 0), b3, voffB);
            PG8_BAR; PG8_WAIT_L(0); PG8_MMA(0, 1, At, B1); PG8_BAR;
            PG8_LDA(At, 1, 1); PG8_STAGE(PG8_SA(1, 0), a3, voffA);
            PG8_BAR; PG8_WAIT_L(0); PG8_MMA(1, 0, At, B0); PG8_BAR; PG8_SCHED;
            PG8_STAGE(PG8_SB(1, 1), b3 + hstep, voffB);
            PG8_WAIT_V(6); PG8_BAR; PG8_MMA(1, 1, At, B1); PG8_BAR;
            }
        }
        if constexpr (ALIGN_EPI) { if (wr == 0) PG8_BAR; }
        if constexpr (!Epi::AFTER_DRAIN) { E(acc, cur, wr, wc, fr, fq); S.done(cur); }
        if (!has_next) break;
#pragma unroll
        for (int a = 0; a < 2; ++a)
#pragma unroll
            for (int b = 0; b < 2; ++b)
#pragma unroll
                for (int m = 0; m < 4; ++m)
#pragma unroll
                    for (int n = 0; n < 2; ++n) acc[a][b][m][n] = (f32x4){0.f, 0.f, 0.f, 0.f};
        cur = nxt; cA = nA; cB = nB; ++ui;
        if constexpr (ALIGN_EPI) { if (wr == 1) PG8_BAR; }
    }
    PG8_WAIT_V(0);
    if constexpr (!ALIGN_EPI) { if (wr == 0) PG8_BAR; }
    PG8_BAR;
    if constexpr (Epi::AFTER_DRAIN) { E.fused(acc, cur, wr, wc, fr, fq, lds, wid, lane); S.done(cur); }
#undef PG8_SA
#undef PG8_SB
#undef PG8_STAGE
#undef PG8_LDA
#undef PG8_LDB
#undef PG8_MMA
#undef PG8_WAIT_V
#undef PG8_WAIT_L
#undef PG8_BAR
#undef PG8_SCHED
}
}

enum { WM_IN = 0, WM_PLAIN = 1, WM_GATE = 2, WM_UP = 3, WM_MD = 4, WM_UQ = 5, WM_UKV = 6 };
__device__ __forceinline__ int wmap_row(int mode, int n) {
    switch (mode) {
        case WM_GATE: return (n >> 7) * 256 + (n & 127);
        case WM_UP: return (n >> 7) * 256 + 128 + (n & 127);
        case WM_MD: return n < 384 ? n : (n < 640 ? n + 128 : n - 256);
        case WM_UQ: { const int h = n / 96, e = n % 96; return e < 64 ? h * 64 + e : 1024 + h * 32 + (e - 64); }
        case WM_UKV: { const int h = n >> 7, e = n & 127; return e < 64 ? h * 64 + e : 1024 + h * 64 + (e - 64); }
        default: return n;
    }
}
__device__ __forceinline__ float wmap_scale(int mode, int n) {
    if (mode == WM_IN) return (n < 512 || (n >= 1536 && n < 2048)) ? 0.125f * LOG2E : 1.0f;
    if (mode == WM_UQ) return 0.10206207261596577f * LOG2E;
    return 1.0f;
}
struct WJob { const float* W; const float* gain; int K, N; bf16* WT; int mode; };
__device__ __forceinline__ void p0_convert_item(const WJob& w, int item, int lane) {
    const int nblk = (w.N + 63) >> 6, kb = item / nblk, nb = item - kb * nblk, k0 = 64 * kb, n = nb * 64 + lane;
    const bool ok = n < w.N;
    const float* src = w.W + (size_t)k0 * w.N + (ok ? n : 0);
    float v[64];
#pragma unroll
    for (int t = 0; t < 64; ++t) v[t] = src[(size_t)t * w.N];
    if (w.gain) {
#pragma unroll
        for (int t = 0; t < 64; ++t) v[t] *= w.gain[k0 + t];
    }
    const float sc = wmap_scale(w.mode, n);
    if (ok) { bf16* dst = w.WT + (size_t)wmap_row(w.mode, n) * w.K + k0;
#pragma unroll
        for (int c = 0; c < 8; ++c) *(u32x4*)(dst + 8 * c) = (u32x4){cvtpk_g(v[8 * c] * sc, v[8 * c + 1] * sc), cvtpk_g(v[8 * c + 2] * sc, v[8 * c + 3] * sc), cvtpk_g(v[8 * c + 4] * sc, v[8 * c + 5] * sc), cvtpk_g(v[8 * c + 6] * sc, v[8 * c + 7] * sc)}; }
}
__device__ __forceinline__ WJob wjob(const Frame& F, int j) {
    switch (j) {
        case 0: return WJob{F.w_in, F.attn_norm, DM, N0, F.W_IN, WM_IN};
        case 1: return WJob{F.w_out, nullptr, DM, DM, F.W_OUT, WM_PLAIN};
        case 2: return WJob{F.w_gate, F.ffn_norm, DM, FFH, F.W_GU0, WM_GATE};
        case 3: return WJob{F.w_up, F.ffn_norm, DM, FFH, F.W_GU0, WM_UP};
        case 4: return WJob{F.w_down, nullptr, FFH, DM, F.W_DN0, WM_PLAIN};
        case 5: return WJob{F.w_md, F.attn_norm + DM, DM, 672, F.W_MD, WM_MD};
        case 6: return WJob{F.w_uq, F.q_norm, QRANK, NUQ, F.W_UQ, WM_UQ};
        case 7: return WJob{F.w_ukv, F.kv_norm, KVRANK, NUKV, F.W_UKV, WM_UKV};
        case 8: return WJob{F.w_o, nullptr, DM, DM, F.W_O, WM_PLAIN};
        case 9: return WJob{F.w_gate + (size_t)DM * FFH, F.ffn_norm + DM, DM, FFH, F.W_GU1, WM_GATE};
        case 10: return WJob{F.w_up + (size_t)DM * FFH, F.ffn_norm + DM, DM, FFH, F.W_GU1, WM_UP};
        default: return WJob{F.w_down + (size_t)FFH * DM, nullptr, FFH, DM, F.W_DN1, WM_PLAIN};
    }
}
__device__ __forceinline__ void p0_prologue(const Frame& F, LAS unsigned char* lds) {
    const int gw = F.bid * NWAVES + F.wave, NGW = F.G * NWAVES;
    { int it = gw, base = 0;
#pragma unroll
      for (int j = 0; j < 12; ++j) { const WJob w = wjob(F, j); const int end = base + (w.K / 64) * ((w.N + 63) / 64);
          for (; it < end; it += NGW) p0_convert_item(w, it - base, F.lane);
          base = end; } }
    for (int i = gw * 64 + F.lane; i < 96 * DM / 8; i += NGW * 64) *(u32x4*)(F.W_MD + (size_t)416 * DM + (size_t)i * 8) = (u32x4){0u, 0u, 0u, 0u};
    for (int m = gw; m < M; m += NGW) {
        const f32x4* xr = (const f32x4*)(F.x + (size_t)m * DM) + F.lane; f32x4 v[4]; float s = 0.f;
#pragma unroll
        for (int j = 0; j < 4; ++j) { v[j] = xr[64 * j]; s += (v[j].x * v[j].x + v[j].y * v[j].y) + (v[j].z * v[j].z + v[j].w * v[j].w); }
        s = wave_sum(s);
        u32x2* o8 = (u32x2*)(F.XN + (size_t)m * DM) + F.lane;
#pragma unroll
        for (int j = 0; j < 4; ++j) o8[64 * j] = (u32x2){cvtpk_g(v[j].x, v[j].y), cvtpk_g(v[j].z, v[j].w)};
        if (F.lane < 16) F.ST[(size_t)m * 16 + F.lane] = F.lane == 0 ? s : 0.f;
    }
    { f32x4* z = (f32x4*)(F.ST + (size_t)M * 16); const int n4 = 6 * M * 16 / 4;
      for (int i = gw * 64 + F.lane; i < n4; i += NGW * 64) z[i] = (f32x4){0.f, 0.f, 0.f, 0.f}; }
    for (int e = gw * 64 + F.lane; e < M * 16; e += NGW * 64) {
        const int row = e >> 4, i = e & 15;
        const float freq = exp2f(-(float)i * 0.83048202372184059f);
        const float ang = (float)F.pos[row] * freq;
        const float nrev = rintf(ang * 0.15915494309189535f);
        float r = fmaf(-nrev, 6.28125f, ang); r = fmaf(-nrev, 0.0019353071795864769f, r);
        const float rf = r * 0.15915494309189535f;
        F.CS[e] = (f32x2){__builtin_amdgcn_cosf(rf), __builtin_amdgcn_sinf(rf)};
    }
}

enum { G_ROWSCALE = 0, G_SWIGLU = 1, G_RESID = 2 };
struct GemmDesc { const bf16* A; const bf16* Bt; int N, K; int kind; int rmode; const float* stat; int nslots; float inv_dim; const float* base; float* xout; bf16* xn; float* stat_out; bf16* hout; };

__device__ __forceinline__ void naive_gemm_phase(const Frame& F, const GemmDesc g) {
    const int lane = F.lane, fr = lane & 15, fq = lane >> 4;
    const int gw = F.bid * NWAVES + F.wave, NGW = F.G * NWAVES;
    const int K = g.K;
    if (g.kind == G_SWIGLU) {
        const int ncb = FFH / 32, units = (M / 32) * ncb;
        for (int u = gw; u < units; u += NGW) {
            const int r0 = (u / ncb) * 32, j0 = (u % ncb) * 32;
            const int brow = (j0 >> 7) * 256 + (j0 & 127);
            f32x4 ag[2][2], au[2][2];
#pragma unroll
            for (int a = 0; a < 2; ++a)
#pragma unroll
                for (int b = 0; b < 2; ++b) { ag[a][b] = (f32x4){0.f, 0.f, 0.f, 0.f}; au[a][b] = (f32x4){0.f, 0.f, 0.f, 0.f}; }
            for (int k0 = 0; k0 < K; k0 += 32) {
                bf16x8 af[2], bg[2], bu[2];
#pragma unroll
                for (int a = 0; a < 2; ++a) af[a] = *(const bf16x8*)(g.A + (size_t)(r0 + 16 * a + fr) * K + k0 + 8 * fq);
#pragma unroll
                for (int b = 0; b < 2; ++b) { bg[b] = *(const bf16x8*)(g.Bt + (size_t)(brow + 16 * b + fr) * K + k0 + 8 * fq); bu[b] = *(const bf16x8*)(g.Bt + (size_t)(brow + 128 + 16 * b + fr) * K + k0 + 8 * fq); }
#pragma unroll
                for (int a = 0; a < 2; ++a)
#pragma unroll
                    for (int b = 0; b < 2; ++b) { ag[a][b] = __builtin_amdgcn_mfma_f32_16x16x32_bf16(af[a], bg[b], ag[a][b], 0, 0, 0); au[a][b] = __builtin_amdgcn_mfma_f32_16x16x32_bf16(af[a], bu[b], au[a][b], 0, 0, 0); }
            }
#pragma unroll
            for (int a = 0; a < 2; ++a)
#pragma unroll
                for (int r = 0; r < 4; ++r) { const int row = r0 + 16 * a + 4 * fq + r; const float rs = row_rstd(g.stat, row, g.nslots, g.inv_dim);
#pragma unroll
                    for (int b = 0; b < 2; ++b) { const float gv = ag[a][b][r] * rs, uv = au[a][b][r] * rs; const float hv = gv * uv / (1.0f + __builtin_amdgcn_exp2f(-gv * LOG2E));
                        g.hout[(size_t)row * FFH + j0 + 16 * b + fr] = (bf16)f2bf(hv); } }
        }
        return;
    }
    const int ncb = g.N / 64, units = (M / 32) * ncb;
    for (int u = gw; u < units; u += NGW) {
        const int r0 = (u / ncb) * 32, c0 = (u % ncb) * 64;
        f32x4 acc[2][4];
#pragma unroll
        for (int a = 0; a < 2; ++a)
#pragma unroll
            for (int b = 0; b < 4; ++b) acc[a][b] = (f32x4){0.f, 0.f, 0.f, 0.f};
        for (int k0 = 0; k0 < K; k0 += 32) {
            bf16x8 af[2], bfr[4];
#pragma unroll
            for (int a = 0; a < 2; ++a) af[a] = *(const bf16x8*)(g.A + (size_t)(r0 + 16 * a + fr) * K + k0 + 8 * fq);
#pragma unroll
            for (int b = 0; b < 4; ++b) bfr[b] = *(const bf16x8*)(g.Bt + (size_t)(c0 + 16 * b + fr) * K + k0 + 8 * fq);
#pragma unroll
            for (int a = 0; a < 2; ++a)
#pragma unroll
                for (int b = 0; b < 4; ++b) acc[a][b] = __builtin_amdgcn_mfma_f32_16x16x32_bf16(af[a], bfr[b], acc[a][b], 0, 0, 0);
        }
        if (g.kind == G_RESID) {
#pragma unroll
            for (int a = 0; a < 2; ++a)
#pragma unroll
                for (int r = 0; r < 4; ++r) { const int row = r0 + 16 * a + 4 * fq + r; float ss = 0.f;
#pragma unroll
                    for (int b = 0; b < 4; ++b) { const int col = c0 + 16 * b + fr; const size_t o = (size_t)row * DM + col; const float v = g.base[o] + acc[a][b][r]; g.xout[o] = v; if (g.xn) g.xn[o] = (bf16)f2bf(v); ss += v * v; }
                    ss += __shfl_xor(ss, 1); ss += __shfl_xor(ss, 2); ss += __shfl_xor(ss, 4); ss += __shfl_xor(ss, 8);
                    if (fr == 0) atomicAdd(g.stat_out + (size_t)row * 16, ss); }
        } else {
            const int hh = c0 >> 7; const Route rt = route(F, g.rmode, hh); const int cin = c0 & 127;
            if (rt.wc0only && cin != 0) continue;
#pragma unroll
            for (int a = 0; a < 2; ++a)
#pragma unroll
                for (int r = 0; r < 4; ++r) { const int row = r0 + 16 * a + 4 * fq + r; const float rs = row_rstd(g.stat, row, g.nslots, g.inv_dim);
                    float v[4]; float ss = 0.f;
#pragma unroll
                    for (int b = 0; b < 4; ++b) { v[b] = acc[a][b][r] * rs; ss += v[b] * v[b]; }
                    if (rt.rope) { const f32x2 cs = F.CS[(size_t)row * 16 + fr];
#pragma unroll
                        for (int p = 0; p < 2; ++p) { const float x1 = v[2 * p], x2 = v[2 * p + 1]; v[2 * p] = x1 * cs.x - x2 * cs.y; v[2 * p + 1] = x2 * cs.x + x1 * cs.y; } }
#pragma unroll
                    for (int b = 0; b < 4; ++b) { if (rt.wc0only && b >= 2) break; rt.dst[(size_t)row * rt.pitch + rt.col + cin + 16 * b + fr] = (bf16)f2bf(v[b]); }
                    if (rt.stat) { ss += __shfl_xor(ss, 1); ss += __shfl_xor(ss, 2); ss += __shfl_xor(ss, 4); ss += __shfl_xor(ss, 8); if (fr == 0) atomicAdd(rt.stat + (size_t)row * 16, ss); } }
        }
    }
}

__device__ __forceinline__ float dot8(const float* q, const u32x4 c) {
    return q[0] * __builtin_bit_cast(float, c.x << 16) + q[1] * __builtin_bit_cast(float, c.x & 0xffff0000u) + q[2] * __builtin_bit_cast(float, c.y << 16) + q[3] * __builtin_bit_cast(float, c.y & 0xffff0000u)
         + q[4] * __builtin_bit_cast(float, c.z << 16) + q[5] * __builtin_bit_cast(float, c.z & 0xffff0000u) + q[6] * __builtin_bit_cast(float, c.w << 16) + q[7] * __builtin_bit_cast(float, c.w & 0xffff0000u);
}
__device__ __forceinline__ void axpy8(float* o, float al, float p, const u32x4 c) {
    o[0] = o[0] * al + p * __builtin_bit_cast(float, c.x << 16); o[1] = o[1] * al + p * __builtin_bit_cast(float, c.x & 0xffff0000u);
    o[2] = o[2] * al + p * __builtin_bit_cast(float, c.y << 16); o[3] = o[3] * al + p * __builtin_bit_cast(float, c.y & 0xffff0000u);
    o[4] = o[4] * al + p * __builtin_bit_cast(float, c.z << 16); o[5] = o[5] * al + p * __builtin_bit_cast(float, c.z & 0xffff0000u);
    o[6] = o[6] * al + p * __builtin_bit_cast(float, c.w << 16); o[7] = o[7] * al + p * __builtin_bit_cast(float, c.w & 0xffff0000u);
}
__device__ __forceinline__ void naive_sb(const Frame& F) {
    const int gw = F.bid * NWAVES + F.wave, NGW = F.G * NWAVES;
    for (int u = gw; u < BATCH * 8 * (SEQ / 64); u += NGW) {
        const int blk = u % (SEQ / 64), h = (u / (SEQ / 64)) % 8, b = u / (SEQ / 64 * 8);
        const int t = blk * 64 + F.lane; const size_t rowq = (size_t)b * SEQ + t;
        float q[64], o[64];
#pragma unroll
        for (int d = 0; d < 64; ++d) { q[d] = bf2f(F.QKV0[rowq * N0 + h * 64 + d]); o[d] = 0.f; }
        float carry = 0.f;
        for (int s = blk * 64 + 63; s >= 0; --s) {
            const bf16* kr = F.QKV0 + ((size_t)b * SEQ + s) * N0 + 512 + h * 64; const bf16* vr = kr + 512;
            float y = 0.f;
#pragma unroll
            for (int d = 0; d < 8; ++d) y += dot8(q + 8 * d, ((const u32x4*)kr)[d]);
            const bool valid = s < t;
            const float sp = fmaxf(y, 0.f) + __builtin_amdgcn_logf(1.0f + __builtin_amdgcn_exp2f(-fabsf(y)));
            const float w = valid ? __builtin_amdgcn_exp2f((y - sp) + carry) : 0.f;
            if (valid) carry -= sp;
#pragma unroll
            for (int d = 0; d < 8; ++d) axpy8(o + 8 * d, 1.0f, w, ((const u32x4*)vr)[d]);
        }
#pragma unroll
        for (int d = 0; d < 64; ++d) F.AO[rowq * DM + h * 64 + d] = (bf16)f2bf(o[d]);
    }
}
__device__ __forceinline__ float t5_bias2(const Frame& F, int rel, int h) {
    int bk = rel;
    if (rel >= 16) { bk = 16 + (int)(log2f((float)rel * 0.0625f) * (16.0f / 3.0f)); bk = bk > 31 ? 31 : bk; }
    return F.relb[bk * 8 + h] * LOG2E;
}
__device__ __forceinline__ void naive_swa(const Frame& F) {
    const int gw = F.bid * NWAVES + F.wave, NGW = F.G * NWAVES;
    for (int u = gw; u < BATCH * 8 * (SEQ / 64); u += NGW) {
        const int blk = u % (SEQ / 64), h = (u / (SEQ / 64)) % 8, b = u / (SEQ / 64 * 8), kvh = h >> 2;
        const int t = blk * 64 + F.lane; const size_t rowq = (size_t)b * SEQ + t;
        float q[64], o[64];
#pragma unroll
        for (int d = 0; d < 64; ++d) { q[d] = bf2f(F.QKV0[rowq * N0 + 1536 + h * 64 + d]); o[d] = 0.f; }
        float m = F.sinks[h] * LOG2E, l = 1.0f;
        const int s_lo = blk * 64 - 127 < 0 ? 0 : blk * 64 - 127;
        for (int s = s_lo; s <= blk * 64 + 63; ++s) {
            const bf16* kr = F.QKV0 + ((size_t)b * SEQ + s) * N0 + 2048 + kvh * 64; const bf16* vr = kr + 128;
            float y = 0.f;
#pragma unroll
            for (int d = 0; d < 8; ++d) y += dot8(q + 8 * d, ((const u32x4*)kr)[d]);
            const int rel = t - s; const bool valid = rel >= 0 && rel < 128;
            const float lg = valid ? y + t5_bias2(F, rel & 127, h) : -INFINITY;
            const float mn = fmaxf(m, lg), al = __builtin_amdgcn_exp2f(m - mn), p = __builtin_amdgcn_exp2f(lg - mn);
            l = l * al + p; m = mn;
#pragma unroll
            for (int d = 0; d < 8; ++d) axpy8(o + 8 * d, al, p, ((const u32x4*)vr)[d]);
        }
        const float il = 1.0f / l;
#pragma unroll
        for (int d = 0; d < 64; ++d) F.AO[rowq * DM + 512 + h * 64 + d] = (bf16)f2bf(o[d] * il);
    }
}
__device__ __forceinline__ void naive_mla(const Frame& F) {
    const int gw = F.bid * NWAVES + F.wave, NGW = F.G * NWAVES;
    for (int u = gw; u < BATCH * 16 * (SEQ / 64); u += NGW) {
        const int blk = (SEQ / 64 - 1) - u % (SEQ / 64), h = (u / (SEQ / 64)) % 16, b = u / (SEQ / 64 * 16);
        const int t = blk * 64 + F.lane; const size_t rowq = (size_t)b * SEQ + t;
        float q[96], o[64];
#pragma unroll
        for (int d = 0; d < 64; ++d) { q[d] = bf2f(F.QN[rowq * 1024 + h * 64 + d]); o[d] = 0.f; }
#pragma unroll
        for (int d = 0; d < 32; ++d) q[64 + d] = bf2f(F.QR[rowq * 512 + h * 32 + d]);
        float m = -1e30f, l = 0.f;
        for (int s = 0; s <= blk * 64 + 63; ++s) {
            const size_t rk = (size_t)b * SEQ + s; const bf16* kn = F.KN + rk * 1024 + h * 64; const bf16* kr = F.KR + rk * 32; const bf16* vr = F.VV + rk * 1024 + h * 64;
            float y = 0.f;
#pragma unroll
            for (int d = 0; d < 8; ++d) y += dot8(q + 8 * d, ((const u32x4*)kn)[d]);
#pragma unroll
            for (int d = 0; d < 4; ++d) y += dot8(q + 64 + 8 * d, ((const u32x4*)kr)[d]);
            const float lg = s <= t ? y : -INFINITY;
            const float mn = fmaxf(m, lg), al = __builtin_amdgcn_exp2f(m - mn), p = __builtin_amdgcn_exp2f(lg - mn);
            l = l * al + p; m = mn;
#pragma unroll
            for (int d = 0; d < 8; ++d) axpy8(o + 8 * d, al, p, ((const u32x4*)vr)[d]);
        }
        const float il = 1.0f / l;
#pragma unroll
        for (int d = 0; d < 64; ++d) F.AO[rowq * DM + h * 64 + d] = (bf16)f2bf(o[d] * il);
    }
}
__device__ __forceinline__ void final_norm_phase(const Frame& F) {
    const int gw = F.bid * NWAVES + F.wave, NGW = F.G * NWAVES;
    for (int m = gw; m < M; m += NGW) {
        const float rs = row_rstd(F.ST + (size_t)4 * M * 16, m, 16, 1.0f / DM);
        f32x4* xr = (f32x4*)(F.out + (size_t)m * DM) + F.lane; const f32x4* gr = (const f32x4*)F.final_norm + F.lane;
#pragma unroll
        for (int j = 0; j < 4; ++j) { const f32x4 v = xr[64 * j], g = gr[64 * j]; xr[64 * j] = v * rs * g; }
    }
}

namespace att {
typedef float f32x16 __attribute__((ext_vector_type(16)));
typedef short v4i16_t __attribute__((ext_vector_type(4)));
typedef __bf16 bf16x2_t __attribute__((ext_vector_type(2)));
constexpr int NSLOT = 3, SLOT_K = 12288, SLOT_V = 8192, OFF_K = 0, OFF_V = NSLOT * SLOT_K, OFF_FLAG = OFF_V + NSLOT * SLOT_V, OFF_TB = OFF_FLAG + 64, ATT_LDS = OFF_TB + 512;
__device__ __forceinline__ unsigned cvtpk(float lo, float hi) { f32x2 v = {lo, hi}; bf16x2_t b = __builtin_convertvector(v, bf16x2_t); return __builtin_bit_cast(unsigned, b); }
__device__ __forceinline__ void glds16(const void* gsrc, unsigned lds_dst) { unsigned keep;
    asm volatile("s_mov_b32 %0, m0\n\ts_mov_b32 m0, %2\n\ts_nop 0\n\tglobal_load_lds_dwordx4 %1, off\n\ts_mov_b32 m0, %0" : "=&s"(keep) : "v"(gsrc), "s"(lds_dst) : "memory"); }
#define ATT_WAIT_BAR(N) asm volatile("s_waitcnt vmcnt(" #N ") lgkmcnt(0)\n\ts_barrier" ::: "memory")
__device__ __forceinline__ int crow(int r, int hi) { return (r & 3) + 8 * (r >> 2) + 4 * hi; }

template <int MODE> __device__ __forceinline__ void attn_unit(const Frame& F, LAS unsigned char* lds, int b, int h, int qb) {
    const int tid = F.tid, lane = F.lane, wid = F.wave, r32 = lane & 31, hi = lane >> 5;
    constexpr int ND2 = MODE == 2 ? 6 : 4;
    const int q0 = qb * 256, qw0 = q0 + 32 * wid, qg = qw0 + r32;
    const size_t rowq = (size_t)b * SEQ + qg, rowb = (size_t)b * SEQ;
    const bf16 *Qp, *Qr = nullptr, *Kb, *Vb, *KRb = nullptr; int pK, pV; bf16* Op;
    if (MODE == 0) { Qp = F.QKV0 + rowq * N0 + h * 64; Kb = F.QKV0 + rowb * N0 + 512 + h * 64; Vb = Kb + 512; pK = pV = N0; Op = F.AO + rowq * DM + h * 64; }
    else if (MODE == 1) { Qp = F.QKV0 + rowq * N0 + 1536 + h * 64; Kb = F.QKV0 + rowb * N0 + 2048 + (h >> 2) * 64; Vb = Kb + 128; pK = pV = N0; Op = F.AO + rowq * DM + 512 + h * 64; }
    else { Qp = F.QN + rowq * 1024 + h * 64; Qr = F.QR + rowq * 512 + h * 32; Kb = F.KN + rowb * 1024 + h * 64; KRb = F.KR + rowb * 32; Vb = F.VV + rowb * 1024 + h * 64; pK = pV = 1024; Op = F.AO + rowq * DM + h * 64; }
    int t_first, t_step, NT;
    if (MODE == 0) { t_first = q0 / 64 + 3; t_step = -1; NT = q0 / 64 + 4; }
    else if (MODE == 1) { const int tlo = q0 / 64 - 2 < 0 ? 0 : q0 / 64 - 2; t_first = tlo; t_step = 1; NT = q0 / 64 + 4 - tlo; }
    else { t_first = 0; t_step = 1; NT = q0 / 64 + 4; }
    const bf16* ksrc = Kb + (size_t)lane * pK + wid * 8;
    const bf16* krsrc = MODE == 2 ? KRb + (size_t)lane * 32 + (wid & 3) * 8 : nullptr;
    const bf16* vsrc = Vb + (size_t)(16 * (wid & 3) + (lane >> 2)) * pV + (wid >> 2) * 32 + (lane & 3) * 8;
    const unsigned lds0 = (unsigned)(uintptr_t)lds;
#define ATT_ISSUE(ti, slot) do { const int kb_ = 64 * (ti); const unsigned so_ = (unsigned)(slot); \
        glds16(ksrc + (size_t)kb_ * pK, (unsigned)__builtin_amdgcn_readfirstlane(lds0 + OFF_K + so_ * SLOT_K + wid * 1024)); \
        if (MODE == 2 && wid < 4) glds16(krsrc + (size_t)kb_ * 32, (unsigned)__builtin_amdgcn_readfirstlane(lds0 + OFF_K + so_ * SLOT_K + (8 + wid) * 1024)); \
        glds16(vsrc + (size_t)kb_ * pV, (unsigned)__builtin_amdgcn_readfirstlane(lds0 + OFF_V + so_ * SLOT_V + wid * 1024)); } while (0)
    ATT_ISSUE(t_first, 0);
    if (NT > 1) ATT_ISSUE(t_first + t_step, 1);
    bf16x8 qr[ND2];
#pragma unroll
    for (int c2 = 0; c2 < 4; ++c2) qr[c2] = *(const bf16x8*)(Qp + 16 * c2 + 8 * hi);
    if (MODE == 2) { qr[ND2 - 2] = *(const bf16x8*)(Qr + 8 * hi); qr[ND2 - 1] = *(const bf16x8*)(Qr + 16 + 8 * hi); }
    LAS float* tb = (LAS float*)(lds + OFF_TB);
    volatile LAS unsigned* flg = (volatile LAS unsigned*)(lds + OFF_FLAG);
    if (MODE == 1 && tid < 128) tb[tid] = t5_bias2(F, tid, h);
    f32x16 o[2]; o[0] = f32x16{}; o[1] = f32x16{};
    float m_run = MODE == 1 ? F.sinks[h] * LOG2E : -1e30f, l_run = (MODE == 1 && hi == 0) ? 1.0f : 0.0f, C = 1.0f;
    const LAS unsigned char* kp0 = lds + OFF_K + hi * 1024 + r32 * 16;
    const LAS unsigned char* vp0 = lds + OFF_V + ((lane >> 4) & 1) * 32 + (lane & 3) * 8 + (4 * hi + ((lane & 15) >> 2)) * 64;
    int slot = 0;
    for (int i = 0; i < NT; ++i) {
        if (i == 0 || i + 1 >= NT) ATT_WAIT_BAR(0);
        else if (MODE == 2 && wid < 4) ATT_WAIT_BAR(3);
        else ATT_WAIT_BAR(2);
        if (MODE == 0 && i > 0) { const LAS unsigned* fp = (const LAS unsigned*)(lds + OFF_FLAG) + ((i - 1) & 1) * 8; unsigned a = 1u;
#pragma unroll
            for (int w = 0; w < 8; ++w) a &= fp[w];
            if (__builtin_amdgcn_readfirstlane(a)) break; }
        if (i + 2 < NT) ATT_ISSUE(t_first + (i + 2) * t_step, slot == 0 ? 2 : slot - 1);
        const int kb = 64 * (t_first + i * t_step);
        bool skip, need_mask;
        if (MODE == 0) { skip = kb >= qw0 + 31; need_mask = kb + 63 >= qw0; }
        else if (MODE == 1) { skip = kb > qw0 + 31 || kb + 63 < qw0 - 127; need_mask = true; }
        else { skip = kb > qw0 + 31; need_mask = kb + 63 > qw0; }
        if (!skip) {
            f32x16 s0 = f32x16{}, s1 = f32x16{};
            const LAS unsigned char* kp = kp0 + slot * SLOT_K;
#pragma unroll
            for (int c2 = 0; c2 < ND2; ++c2) {
                const bf16x8 k0 = *(const LAS bf16x8*)(kp + c2 * 2048), k1 = *(const LAS bf16x8*)(kp + c2 * 2048 + 512);
                s0 = __builtin_amdgcn_mfma_f32_32x32x16_bf16(k0, qr[c2], s0, 0, 0, 0);
                s1 = __builtin_amdgcn_mfma_f32_32x32x16_bf16(k1, qr[c2], s1, 0, 0, 0);
            }
            u32x4 pw[4];
            if (MODE == 0) {
                float om[32], be[32];
#pragma unroll
                for (int r = 0; r < 16; ++r) {
                    { const float e = __builtin_amdgcn_exp2f(fminf(s0[r], 64.0f)), d = __builtin_amdgcn_rcpf(1.0f + e); om[r] = d; be[r] = e * d; }
                    { const float e = __builtin_amdgcn_exp2f(fminf(s1[r], 64.0f)), d = __builtin_amdgcn_rcpf(1.0f + e); om[16 + r] = d; be[16 + r] = e * d; }
                }
                if (need_mask) {
#pragma unroll
                    for (int r = 0; r < 16; ++r) { const int key = kb + crow(r, hi);
                        if (key >= qg) { om[r] = 1.0f; be[r] = 0.0f; }
                        if (key + 32 >= qg) { om[16 + r] = 1.0f; be[16 + r] = 0.0f; } }
                }
                float ga[8], gb[8];
#pragma unroll
                for (int gi = 0; gi < 8; ++gi) { const float gp = (om[4 * gi] * om[4 * gi + 1]) * (om[4 * gi + 2] * om[4 * gi + 3]);
                    const auto rr = __builtin_amdgcn_permlane32_swap(__float_as_uint(gp), __float_as_uint(gp), false, false); ga[gi] = __uint_as_float(rr[0]); gb[gi] = __uint_as_float(rr[1]); }
                float R = C, Rm[8];
#pragma unroll
                for (int gi = 7; gi >= 0; --gi) { const float Rb = R; R *= gb[gi]; const float Ra = R; R *= ga[gi]; Rm[gi] = hi ? Rb : Ra; }
                C = R;
#pragma unroll
                for (int gi = 0; gi < 8; ++gi) { float P = Rm[gi];
                    be[4 * gi + 3] *= P; P *= om[4 * gi + 3]; be[4 * gi + 2] *= P; P *= om[4 * gi + 2]; be[4 * gi + 1] *= P; P *= om[4 * gi + 1]; be[4 * gi] *= P; }
#pragma unroll
                for (int k = 0; k < 4; ++k) pw[k] = (u32x4){cvtpk(be[8 * k], be[8 * k + 1]), cvtpk(be[8 * k + 2], be[8 * k + 3]), cvtpk(be[8 * k + 4], be[8 * k + 5]), cvtpk(be[8 * k + 6], be[8 * k + 7])};
            } else {
                if (MODE == 1) {
#pragma unroll
                    for (int r = 0; r < 16; ++r) { const int rel = qg - (kb + crow(r, hi));
                        s0[r] = (rel >= 0 && rel < 128) ? s0[r] + tb[rel & 127] : -INFINITY;
                        s1[r] = (rel - 32 >= 0 && rel - 32 < 128) ? s1[r] + tb[(rel - 32) & 127] : -INFINITY; }
                } else if (need_mask) {
#pragma unroll
                    for (int r = 0; r < 16; ++r) { const int key = kb + crow(r, hi); if (key > qg) s0[r] = -INFINITY; if (key + 32 > qg) s1[r] = -INFINITY; }
                }
                float mx = fmaxf(s0[0], s1[0]);
#pragma unroll
                for (int r = 1; r < 16; ++r) mx = fmaxf(mx, fmaxf(s0[r], s1[r]));
                { const auto rr = __builtin_amdgcn_permlane32_swap(__float_as_uint(mx), __float_as_uint(mx), false, false); mx = fmaxf(__uint_as_float(rr[0]), __uint_as_float(rr[1])); }
                const float mn = fmaxf(m_run, mx);
                if (__any(mn > m_run)) { const float al = __builtin_amdgcn_exp2f(m_run - mn); l_run *= al; m_run = mn;
#pragma unroll
                    for (int r = 0; r < 16; ++r) { o[0][r] *= al; o[1][r] *= al; } }
                float ls = 0.f;
#pragma unroll
                for (int r = 0; r < 16; ++r) { s0[r] = __builtin_amdgcn_exp2f(s0[r] - m_run); s1[r] = __builtin_amdgcn_exp2f(s1[r] - m_run); ls += s0[r] + s1[r]; }
                l_run += ls;
                pw[0] = (u32x4){cvtpk(s0[0], s0[1]), cvtpk(s0[2], s0[3]), cvtpk(s0[4], s0[5]), cvtpk(s0[6], s0[7])};
                pw[1] = (u32x4){cvtpk(s0[8], s0[9]), cvtpk(s0[10], s0[11]), cvtpk(s0[12], s0[13]), cvtpk(s0[14], s0[15])};
                pw[2] = (u32x4){cvtpk(s1[0], s1[1]), cvtpk(s1[2], s1[3]), cvtpk(s1[4], s1[5]), cvtpk(s1[6], s1[7])};
                pw[3] = (u32x4){cvtpk(s1[8], s1[9]), cvtpk(s1[10], s1[11]), cvtpk(s1[12], s1[13]), cvtpk(s1[14], s1[15])};
            }
            const LAS unsigned char* vp = vp0 + slot * SLOT_V;
#pragma unroll
            for (int dh = 0; dh < 2; ++dh)
#pragma unroll
                for (int ks = 0; ks < 4; ++ks) {
                    const v4i16_t lo = __builtin_amdgcn_ds_read_tr16_b64_v4i16((LAS v4i16_t*)(vp + dh * 4096 + ks * 1024));
                    const v4i16_t hi4 = __builtin_amdgcn_ds_read_tr16_b64_v4i16((LAS v4i16_t*)(vp + dh * 4096 + ks * 1024 + 512));
                    const bf16x8 vf = (bf16x8){lo[0], lo[1], lo[2], lo[3], hi4[0], hi4[1], hi4[2], hi4[3]};
                    o[dh] = __builtin_amdgcn_mfma_f32_32x32x16_bf16(vf, __builtin_bit_cast(bf16x8, pw[ks]), o[dh], 0, 0, 0);
                }
        }
        if (MODE == 0) { const unsigned small = __all(C < 1.17549435e-38f) ? 1u : 0u; if (lane == 0) flg[(i & 1) * 8 + wid] = small; }
        slot = slot == 2 ? 0 : slot + 1;
    }
    float sc = 1.0f;
    if (MODE != 0) { const auto rr = __builtin_amdgcn_permlane32_swap(__float_as_uint(l_run), __float_as_uint(l_run), false, false); sc = 1.0f / (__uint_as_float(rr[0]) + __uint_as_float(rr[1])); }
#pragma unroll
    for (int dh = 0; dh < 2; ++dh)
#pragma unroll
        for (int g = 0; g < 4; ++g)
            *(u32x2*)(Op + 32 * dh + 8 * g + 4 * hi) = (u32x2){cvtpk(o[dh][4 * g] * sc, o[dh][4 * g + 1] * sc), cvtpk(o[dh][4 * g + 2] * sc, o[dh][4 * g + 3] * sc)};
    ATT_WAIT_BAR(0);
#undef ATT_ISSUE
}
__device__ __forceinline__ void attn0_phase(const Frame& F, LAS unsigned char* lds) {
    const int vcu = (F.G % 8 == 0) ? (F.bid % 8) * (F.G / 8) + F.bid / 8 : F.bid;
    for (int p = vcu; p < 256; p += F.G) { const int bh = p >> 3, s = p & 7, b = bh >> 3, h = bh & 7;
#if USE_FAST_SB
        for (int k = 0; k < 2; ++k) attn_unit<0>(F, lds, b, h, k ? s : 15 - s);
#endif
#if USE_FAST_SWA
        for (int k = 0; k < 2; ++k) attn_unit<1>(F, lds, b, h, k ? s : 15 - s);
#endif
    }
}
__device__ __forceinline__ void attn1_phase(const Frame& F, LAS unsigned char* lds) {
    const int vcu = (F.G % 8 == 0) ? (F.bid % 8) * (F.G / 8) + F.bid / 8 : F.bid;
    for (int p = vcu; p < 256; p += F.G) { const int bh = p >> 2, s = p & 3, b = bh >> 4, h = bh & 15;
        for (int k = 0; k < 4; ++k) attn_unit<2>(F, lds, b, h, k == 0 ? 15 - s : (k == 1 ? 11 - s : (k == 2 ? 4 + s : s))); }
}
}

#define RLX_AGENT __ATOMIC_RELAXED, __HIP_MEMORY_SCOPE_AGENT
#define XB_TMO      128
#define XB_XCNT(j)  (256  + 64 * (j))
#define XB_XSUB(j)  (1280 + 64 * (j))
#define XB_XGEN(j)  (2304 + 64 * (j))
#define XB_TOP      3328
#define XB_TOPGEN   3392
#define XCD_BAR_WORDS 3456
#define XB_SPIN_CAP (1u << 22)
__device__ __forceinline__ unsigned xb_ld(unsigned* p)              { return __hip_atomic_load(p, __ATOMIC_RELAXED, __HIP_MEMORY_SCOPE_AGENT); }
__device__ __forceinline__ unsigned xb_add(unsigned* p, unsigned v) { return __hip_atomic_fetch_add(p, v, __ATOMIC_RELAXED, __HIP_MEMORY_SCOPE_AGENT); }
__device__ __forceinline__ unsigned xb_xcc_id() { return (unsigned)__builtin_amdgcn_s_getreg((3 << 11) | 20) & 0xFu; }
#define XB_SPIN(cond, bar) do { unsigned _sp = 0; while (cond) { __builtin_amdgcn_s_sleep(1); \
    if ((++_sp & 255u) == 0u) { if (xb_ld(&(bar)[XB_TMO])) break; if (_sp > XB_SPIN_CAP) { atomicAdd(&(bar)[XB_TMO], 1u); break; } } } } while (0)
struct XcdBarrier { unsigned* bar; unsigned x; volatile LAS unsigned* st; };
__device__ __forceinline__ XcdBarrier xcd_barrier_post(unsigned* bar, volatile LAS unsigned* st) {
    XcdBarrier b; b.bar = bar; b.x = xb_xcc_id(); b.st = st;
    if (threadIdx.x == 0) (void)xb_add(&bar[XB_XCNT(b.x)], 1u);
    return b;
}
__device__ __forceinline__ void xcd_barrier_complete(unsigned* bar, unsigned x, unsigned& nloc, unsigned& nx) {
    const unsigned G = gridDim.x * gridDim.y * gridDim.z;
    unsigned sum, cnt, mine, sp = 0u;
    for (;;) {
        sum = 0u; cnt = 0u; mine = 0u;
#pragma unroll
        for (unsigned j = 0; j < 16; ++j) { const unsigned c = xb_ld(&bar[XB_XCNT(j)]); sum += c; cnt += (c > 0u) ? 1u : 0u; mine = (j == x) ? c : mine; }
        if (sum == G) break;
        __builtin_amdgcn_s_sleep(1);
        if ((++sp & 255u) == 0u) { if (xb_ld(&bar[XB_TMO])) break; if (sp > XB_SPIN_CAP) { atomicAdd(&bar[XB_TMO], 1u); break; } }
    }
    nloc = mine > 0u ? mine : 1u; nx = cnt > 0u ? cnt : 1u;
}
__device__ __forceinline__ void xcd_barrier(const XcdBarrier& b) {
    asm volatile("s_waitcnt vmcnt(0)" ::: "memory");
    __syncthreads();
    if (threadIdx.x == 0) {
        unsigned* bar = b.bar;
        __builtin_amdgcn_s_waitcnt(0);
        unsigned nloc = b.st[0], nx = b.st[1];
        if (nloc == 0u) { xcd_barrier_complete(bar, b.x, nloc, nx); b.st[0] = nloc; b.st[1] = nx; }
        const unsigned old = xb_add(&bar[XB_XSUB(b.x)], 1u);
        const unsigned gen = old / nloc;
        if (old + 1u == (gen + 1u) * nloc) {
            __builtin_amdgcn_fence(__ATOMIC_RELEASE, "agent");
            asm volatile("s_waitcnt vmcnt(0)" ::: "memory");
            const unsigned og = xb_add(&bar[XB_TOP], 1u);
            const unsigned tg = og / nx;
            if (og + 1u == (tg + 1u) * nx) xb_add(&bar[XB_TOPGEN], 1u);
            else XB_SPIN(xb_ld(&bar[XB_TOPGEN]) == tg, bar);
            __builtin_amdgcn_fence(__ATOMIC_ACQUIRE, "agent");
            xb_add(&bar[XB_XGEN(b.x)], 1u);
            asm volatile("s_waitcnt vmcnt(0)" ::: "memory");
        } else {
            XB_SPIN(xb_ld(&bar[XB_XGEN(b.x)]) == gen, bar);
            __builtin_amdgcn_fence(__ATOMIC_ACQUIRE, "agent");
            asm volatile("s_waitcnt vmcnt(0)" ::: "memory");
        }
    }
    __syncthreads();
}
constexpr int RING_BYTES = 131072, LDSCTL_OFF = RING_BYTES, MISC_OFF = LDSCTL_OFF + 320;
constexpr int LDS_BYTES = 147456;
constexpr int CW_BAR = 4096;

constexpr int N_PHASES = 14;
__device__ __forceinline__ GemmDesc gemm_desc(const Frame& F, int ph) {
    GemmDesc g; float* ST = F.ST; const size_t S1 = (size_t)M * 16;
    g.A = F.XN; g.Bt = F.W_IN; g.N = DM; g.K = DM; g.kind = G_RESID; g.rmode = 0; g.stat = ST; g.nslots = 16; g.inv_dim = 1.0f / DM;
    g.base = F.out; g.xout = F.out; g.xn = F.XN; g.stat_out = ST; g.hout = F.H;
    if (ph == 1) { g.Bt = F.W_IN; g.N = N0; g.kind = G_ROWSCALE; g.rmode = R_QKV0; }
    else if (ph == 3) { g.A = F.AO; g.Bt = F.W_OUT; g.base = F.x; g.stat_out = ST + S1; }
    else if (ph == 4) { g.Bt = F.W_GU0; g.N = NGU; g.kind = G_SWIGLU; g.stat = ST + S1; }
    else if (ph == 5) { g.A = F.H; g.Bt = F.W_DN0; g.K = FFH; g.stat_out = ST + 2 * S1; }
    else if (ph == 6) { g.Bt = F.W_MD; g.N = NMD; g.kind = G_ROWSCALE; g.rmode = R_MD; g.stat = ST + 2 * S1; }
    else if (ph == 7) { g.A = F.CQ; g.Bt = F.W_UQ; g.N = NUQ; g.K = QRANK; g.kind = G_ROWSCALE; g.rmode = R_UQ; g.stat = F.SQ; g.nslots = 12; g.inv_dim = 1.0f / QRANK; }
    else if (ph == 8) { g.A = F.CKV; g.Bt = F.W_UKV; g.N = NUKV; g.K = KVRANK; g.kind = G_ROWSCALE; g.rmode = R_UKV; g.stat = F.SKV; g.nslots = 8; g.inv_dim = 1.0f / KVRANK; }
    else if (ph == 10) { g.A = F.AO; g.Bt = F.W_O; g.stat_out = ST + 3 * S1; }
    else if (ph == 11) { g.Bt = F.W_GU1; g.N = NGU; g.kind = G_SWIGLU; g.stat = ST + 3 * S1; }
    else { g.A = F.H; g.Bt = F.W_DN1; g.K = FFH; g.xn = nullptr; g.stat_out = ST + 4 * S1; }
    return g;
}

struct Args { const void* in[18]; float* out; unsigned char* ws; int ph_lo, ph_hi; };
__global__ void __launch_bounds__(NTHR, 2) mk_fwd(Args a) {
    extern __shared__ __attribute__((aligned(16))) unsigned char lds_raw[];
    LAS unsigned char* lds = (LAS unsigned char*)lds_raw;
    Frame F;
    F.tid = threadIdx.x; F.lane = F.tid & 63; F.wave = __builtin_amdgcn_readfirstlane(F.tid >> 6); F.G = gridDim.x; F.bid = blockIdx.x;
    F.x = (const float*)a.in[0]; F.pos = (const int*)a.in[1]; F.attn_norm = (const float*)a.in[2]; F.ffn_norm = (const float*)a.in[3]; F.w_in = (const float*)a.in[4]; F.sinks = (const float*)a.in[5];
    F.w_out = (const float*)a.in[6]; F.relb = (const float*)a.in[7]; F.w_md = (const float*)a.in[8]; F.q_norm = (const float*)a.in[9]; F.w_uq = (const float*)a.in[10]; F.kv_norm = (const float*)a.in[11];
    F.w_ukv = (const float*)a.in[12]; F.w_o = (const float*)a.in[13]; F.w_gate = (const float*)a.in[14]; F.w_up = (const float*)a.in[15]; F.w_down = (const float*)a.in[16]; F.final_norm = (const float*)a.in[17];
    F.out = a.out; F.ws = a.ws; unsigned char* ws = a.ws;
    F.W_IN = (bf16*)(ws + WS_W_IN); F.W_OUT = (bf16*)(ws + WS_W_OUT); F.W_GU0 = (bf16*)(ws + WS_W_GU0); F.W_DN0 = (bf16*)(ws + WS_W_DN0); F.W_MD = (bf16*)(ws + WS_W_MD);
    F.W_UQ = (bf16*)(ws + WS_W_UQ); F.W_UKV = (bf16*)(ws + WS_W_UKV); F.W_O = (bf16*)(ws + WS_W_O); F.W_GU1 = (bf16*)(ws + WS_W_GU1); F.W_DN1 = (bf16*)(ws + WS_W_DN1);
    F.ST = (float*)(ws + WS_ST); F.SQ = (float*)(ws + WS_SQ); F.SKV = (float*)(ws + WS_SKV); F.CS = (f32x2*)(ws + WS_CS);
    F.XN = (bf16*)(ws + WS_XN); F.AO = (bf16*)(ws + WS_AO); F.QKV0 = (bf16*)(ws + WS_QKV0); F.H = (bf16*)(ws + WS_H); F.CQ = (bf16*)(ws + WS_CQ); F.CKV = (bf16*)(ws + WS_CKV);
    F.KR = (bf16*)(ws + WS_KR); F.QN = (bf16*)(ws + WS_QN); F.QR = (bf16*)(ws + WS_QR); F.KN = (bf16*)(ws + WS_KN); F.VV = (bf16*)(ws + WS_VV);

    for (int u = F.tid; u < (LDS_BYTES - LDSCTL_OFF) / 4; u += NTHR) ((LAS unsigned*)(lds + LDSCTL_OFF))[u] = 0u;
    __syncthreads();
    XcdBarrier bar; bar.bar = (unsigned*)(ws + WS_CTL) + CW_BAR; bar.x = 0; bar.st = nullptr;
    if (a.ph_hi - a.ph_lo > 1) bar = xcd_barrier_post((unsigned*)(ws + WS_CTL) + CW_BAR, (volatile LAS unsigned*)(lds + MISC_OFF) + 8);
    for (int ph = a.ph_lo; ph < a.ph_hi; ++ph) {
#if PROBE_MASK
      for (int rep = 0; rep <= ((PROBE_MASK >> ph) & 1); ++rep) {
        if (rep) xcd_barrier(bar);
#endif
        { int t_; asm volatile("v_mov_b32 %0, %1" : "=v"(t_) : "v"(threadIdx.x)); F.tid = t_; F.lane = t_ & 63; }
        if (ph == 0) p0_prologue(F, lds);
        else if (ph == 2) {
#if !USE_FAST_SB
            naive_sb(F);
#endif
#if !USE_FAST_SWA
            naive_swa(F);
#endif
#if USE_FAST_SB || USE_FAST_SWA
            att::attn0_phase(F, lds);
#endif
        }
        else if (ph == 9) {
#if USE_FAST_MLA
            att::attn1_phase(F, lds);
#else
            naive_mla(F);
#endif
        }
        else if (ph == 13) final_norm_phase(F);
        else {
            const GemmDesc g = gemm_desc(F, ph);
#if USE_FAST_GEMM
            const pg8::Gemm pg{g.A, g.Bt, M, g.N, g.K}; pg8::StaticOrder S; S.init(M, g.N, F.G, F.bid);
            if (g.kind == G_ROWSCALE) { const pg8::EpiRowScale E{&F, g.rmode, g.stat, g.nslots, g.inv_dim}; pg8::gemm_phase<pg8::EpiRowScale, pg8::StaticOrder, true, true>(lds, pg, S, E); }
            else if (g.kind == G_SWIGLU) { const pg8::EpiSwiGLU E{g.hout, g.stat, g.nslots, g.inv_dim}; pg8::gemm_phase<pg8::EpiSwiGLU, pg8::StaticOrder, true, true>(lds, pg, S, E); }
            else { const pg8::EpiResid E{g.base, g.xout, g.xn, g.stat_out}; pg8::gemm_phase<pg8::EpiResid, pg8::StaticOrder, true, true>(lds, pg, S, E); }
#else
            naive_gemm_phase(F, g);
#endif
        }
#if PROBE_MASK
      }
#endif
        if (ph + 1 < a.ph_hi && ph != 7) xcd_barrier(bar);
    }
}

extern "C" void kernel_launch(void* const* d_in, const int* in_sizes, int n_in, void* d_out, int out_size, void* d_ws, size_t ws_size, hipStream_t stream) {
    static int grid = 0;
    if (grid == 0) {
        if (n_in != 18 || in_sizes[0] != M * DM || out_size != M * DM || ws_size < WS_END) { fprintf(stderr, "kernel_launch: unexpected problem shape / workspace (n_in %d, ws %zu)\n", n_in, ws_size); grid = -1; return; }
        int dev = 0, cus = 0;
        if (hipGetDevice(&dev) != hipSuccess || hipDeviceGetAttribute(&cus, hipDeviceAttributeMultiprocessorCount, dev) != hipSuccess) { grid = -1; return; }
        if (hipFuncSetAttribute((const void*)mk_fwd, hipFuncAttributeMaxDynamicSharedMemorySize, LDS_BYTES) != hipSuccess) { fprintf(stderr, "kernel_launch: hipFuncSetAttribute failed\n"); grid = -1; return; }
        grid = cus;
    }
    if (grid < 0) return;
    Args a{};
    for (int i = 0; i < 18; ++i) a.in[i] = d_in[i];
    a.out = (float*)d_out; a.ws = (unsigned char*)d_ws;
#if MK_ONE_LAUNCH
    if (hipMemsetAsync((char*)d_ws + WS_CTL, 0, 65536, stream) != hipSuccess) { fprintf(stderr, "kernel_launch: memset failed\n"); return; }
    a.ph_lo = 0; a.ph_hi = N_PHASES;
    void* kargs[] = {&a};
    const hipError_t e = hipLaunchCooperativeKernel((const void*)mk_fwd, dim3(grid), dim3(NTHR), kargs, LDS_BYTES, stream);
    if (e != hipSuccess) fprintf(stderr, "kernel_launch: cooperative launch failed: %s (grid %d)\n", hipGetErrorString(e), grid);
#else
    for (int ph = 0; ph < N_PHASES; ++ph) {
        a.ph_lo = ph; a.ph_hi = ph + 1;
        hipLaunchKernelGGL(mk_fwd, dim3(grid), dim3(NTHR), LDS_BYTES, stream, a);
    }
#endif
}
```

```cpp
#include <hip/hip_runtime.h>
#include <cstdio>
#include <cstdint>

#ifndef MK_ONE_LAUNCH
#define MK_ONE_LAUNCH 1
#endif
#ifndef PROBE_MASK
#define PROBE_MASK 0
#endif
#ifndef USE_FAST_GEMM
#define USE_FAST_GEMM 1
#endif
#ifndef USE_FAST_SB
#define USE_FAST_SB 1
#endif
#ifndef USE_FAST_SWA
#define USE_FAST_SWA 1
#endif
#ifndef USE_FAST_MLA
#define USE_FAST_MLA 1
#endif

#define GAS __attribute__((address_space(1)))
#define LAS __attribute__((address_space(3)))
typedef unsigned short bf16;
typedef short bf16x8 __attribute__((ext_vector_type(8)));
typedef float f32x4 __attribute__((ext_vector_type(4)));
typedef float f32x2 __attribute__((ext_vector_type(2)));
typedef unsigned u32x4 __attribute__((ext_vector_type(4)));
typedef unsigned u32x2 __attribute__((ext_vector_type(2)));

constexpr int BATCH = 4, SEQ = 4096, DM = 1024, M = BATCH * SEQ;
constexpr int N0 = 2304, FFH = 2816, NGU = 2 * FFH, NMD = 768, QRANK = 384, KVRANK = 256, NUQ = 1536, NUKV = 2048;
constexpr float EPS = 1e-6f;
constexpr float LOG2E = 1.4426950408889634f;
constexpr int NWAVES = 8, NTHR = 512;

constexpr size_t MiB = 1u << 20;
constexpr size_t WS_CTL = 0, CTL_ZERO_BYTES = 1 * MiB;
constexpr size_t WS_W_IN = 1 * MiB;
constexpr size_t WS_W_OUT = WS_W_IN + (size_t)N0 * DM * 2;
constexpr size_t WS_W_GU0 = WS_W_OUT + (size_t)DM * DM * 2;
constexpr size_t WS_W_DN0 = WS_W_GU0 + (size_t)NGU * DM * 2;
constexpr size_t WS_W_MD = WS_W_DN0 + (size_t)DM * FFH * 2;
constexpr size_t WS_W_UQ = WS_W_MD + (size_t)NMD * DM * 2;
constexpr size_t WS_W_UKV = WS_W_UQ + (size_t)NUQ * QRANK * 2;
constexpr size_t WS_W_O = WS_W_UKV + (size_t)NUKV * KVRANK * 2;
constexpr size_t WS_W_GU1 = WS_W_O + (size_t)DM * DM * 2;
constexpr size_t WS_W_DN1 = WS_W_GU1 + (size_t)NGU * DM * 2;
constexpr size_t WS_W_END = WS_W_DN1 + (size_t)DM * FFH * 2;
static_assert(WS_W_END <= 47 * MiB, "weights");
constexpr size_t WS_ST = 47 * MiB;
constexpr size_t WS_SQ = 52 * MiB, WS_SKV = 53 * MiB;
constexpr size_t WS_CS = 54 * MiB;
constexpr size_t WS_XN = 56 * MiB;
constexpr size_t WS_AO = 88 * MiB;
constexpr size_t WS_BIG = 120 * MiB;
constexpr size_t WS_QKV0 = WS_BIG;
constexpr size_t WS_H = WS_BIG;
constexpr size_t WS_CQ = WS_BIG;
constexpr size_t WS_CKV = WS_BIG + 12 * MiB;
constexpr size_t WS_KR = WS_BIG + 20 * MiB;
constexpr size_t WS_QN = WS_BIG + 21 * MiB;
constexpr size_t WS_QR = WS_BIG + 53 * MiB;
constexpr size_t WS_KN = WS_BIG + 69 * MiB;
constexpr size_t WS_VV = WS_BIG + 101 * MiB;
constexpr size_t WS_END = WS_BIG + 133 * MiB;
static_assert(WS_END <= 256 * MiB, "d_ws map");

__device__ __forceinline__ unsigned f2bf(float f) { unsigned u = __builtin_bit_cast(unsigned, f); return (u + 0x7fffu + ((u >> 16) & 1u)) >> 16; }
__device__ __forceinline__ unsigned pk2(float lo, float hi) { return f2bf(lo) | (f2bf(hi) << 16); }
typedef __bf16 bf16x2_g __attribute__((ext_vector_type(2)));
__device__ __forceinline__ unsigned cvtpk_g(float lo, float hi) { f32x2 v = {lo, hi}; bf16x2_g b = __builtin_convertvector(v, bf16x2_g); return __builtin_bit_cast(unsigned, b); }
__device__ __forceinline__ float bf2f(unsigned short b) { return __builtin_bit_cast(float, (unsigned)b << 16); }
__device__ __forceinline__ float wave_sum(float v) {
#pragma unroll
    for (int o = 1; o < 64; o <<= 1) v += __shfl_xor(v, o);
    return v;
}

struct Frame {
    int tid, lane, wave, G, bid;
    const float* x; const int* pos; const float* attn_norm; const float* ffn_norm; const float* w_in; const float* sinks; const float* w_out; const float* relb;
    const float* w_md; const float* q_norm; const float* w_uq; const float* kv_norm; const float* w_ukv; const float* w_o; const float* w_gate; const float* w_up; const float* w_down; const float* final_norm;
    float* out; unsigned char* ws;
    bf16 *W_IN, *W_OUT, *W_GU0, *W_DN0, *W_MD, *W_UQ, *W_UKV, *W_O, *W_GU1, *W_DN1;
    float *ST, *SQ, *SKV; f32x2* CS;
    bf16 *XN, *AO, *QKV0, *H, *CQ, *CKV, *KR, *QN, *QR, *KN, *VV;
};

__device__ __forceinline__ float row_rstd(const float* st, int row, int nslots, float inv_dim) {
    const f32x4* p = (const f32x4*)(st + (size_t)row * 16); float s = 0.f;
#pragma unroll
    for (int i = 0; i < 4; ++i) if (4 * i < nslots) { const f32x4 v = p[i]; s += (v.x + v.y) + (v.z + v.w); }
    return 1.0f / sqrtf(s * inv_dim + EPS);
}

enum { R_QKV0 = 0, R_MD = 1, R_UQ = 2, R_UKV = 3 };
struct Route { bf16* dst; int pitch; int col; int rope; int wc0only; float* stat; int slot; };
__device__ __forceinline__ Route route(const Frame& F, int mode, int hh) {
    Route r; r.rope = 0; r.wc0only = 0; r.slot = 0; size_t off, soff = 0; int st = 0;
    if (mode == R_QKV0) { off = WS_QKV0; r.pitch = N0; r.col = hh * 128; }
    else if (mode == R_MD) {
        if (hh < 3) { off = WS_CQ; r.pitch = QRANK; r.col = hh * 128; st = 1; soff = WS_SQ; r.slot = hh * 4; }
        else if (hh == 3) { off = WS_KR; r.pitch = 32; r.col = 0; r.rope = 1; r.wc0only = 1; }
        else { off = WS_CKV; r.pitch = KVRANK; r.col = (hh - 4) * 128; st = 1; soff = WS_SKV; r.slot = (hh - 4) * 4; }
    } else if (mode == R_UQ) {
        if (hh < 8) { off = WS_QN; r.pitch = 1024; r.col = hh * 128; }
        else { off = WS_QR; r.pitch = 512; r.col = (hh - 8) * 128; r.rope = 1; }
    } else {
        if (hh < 8) { off = WS_KN; r.pitch = 1024; r.col = hh * 128; }
        else { off = WS_VV; r.pitch = 1024; r.col = (hh - 8) * 128; }
    }
    r.dst = (bf16*)(F.ws + off); r.stat = st ? (float*)(F.ws + soff) : nullptr;
    return r;
}

namespace pg8 {
#define PG8_LAS __attribute__((address_space(3)))
typedef unsigned short bf16_t;
typedef short bf16x8 __attribute__((ext_vector_type(8)));
typedef float f32x4 __attribute__((ext_vector_type(4)));
typedef unsigned u32x4 __attribute__((ext_vector_type(4)));
constexpr int BM = 256, BK = 64, HALF = 128, HTB = HALF * BK * 2  , STAGE_BYTES = 8 * HTB, NXCD = 8, WGM = 8;

__host__ __device__ __forceinline__ int lds_byte(int r, int c) { const int st = (r >> 4) * 2 + (c >> 5), rr = r & 15, cc = c & 31, ob = rr * 64 + cc * 2; return st * 1024 + (ob ^ (((ob >> 9) & 1) << 5)); }
__host__ __device__ __forceinline__ void stage_rc(int b, int& R, int& C) { const int st = b / 1024, sb = b % 1024, swz = sb ^ (((sb >> 9) & 1) << 5); R = (st >> 1) * 16 + swz / 64; C = (st & 1) * 32 + (swz % 64) / 2; }
__host__ __device__ __forceinline__ int perm32(int rho) { const int n = rho >> 4, i = rho & 15; return 8 * (i >> 2) + 4 * n + (i & 3); }

struct Unit { int pm, pn; };
struct Gemm { const bf16_t* A; const bf16_t* Bt; int M, N, K; };

struct StaticOrder {
    int nM, nN, nwg, G, c;
    __host__ __device__ void init(int M, int N, int G_, int c_) { nM = M / BM; nN = N / BM; nwg = nM * nN; G = G_; c = c_; }
    __host__ __device__ bool next(int i, Unit& u) const {
        const long L = (long)i * G + c; if (L >= nwg) return false;
        int wgid = (int)L; { const int q = nwg / NXCD, r = nwg % NXCD, xcd = wgid % NXCD, off = wgid / NXCD; wgid = (xcd < r ? xcd * (q + 1) : r * (q + 1) + (xcd - r) * q) + off; }
        const int nig = WGM * nN, gid = wgid / nig, fm = gid * WGM, gsz = (nM - fm) < WGM ? (nM - fm) : WGM;
        u.pm = fm + ((wgid % nig) % gsz); u.pn = (wgid % nig) / gsz; return true;
    }
    __device__ __forceinline__ void a_ready(const Unit&) const {}
    __device__ __forceinline__ void done(const Unit&) const {}
};

typedef __bf16 bf16x2_t __attribute__((ext_vector_type(2)));
typedef float f32x2v __attribute__((ext_vector_type(2)));
__device__ __forceinline__ unsigned cvtpk(float lo, float hi) { f32x2v v = {lo, hi}; bf16x2_t b = __builtin_convertvector(v, bf16x2_t); return __builtin_bit_cast(unsigned, b); }

struct EpiRowScale {
    static constexpr bool PERM = true, AFTER_DRAIN = false;
    const ::Frame* F; int rmode; const float* stat; int nslots; float inv_dim;
    __device__ __forceinline__ void operator()(const f32x4 (&acc)[2][2][4][2], const Unit& u, int wr, int wc, int fr, int fq) const {
        const int row0 = u.pm * BM + wr * 64 + fr;
        float rs[2][4];
#pragma unroll
        for (int ai = 0; ai < 2; ++ai)
#pragma unroll
            for (int m = 0; m < 4; ++m) rs[ai][m] = ::row_rstd(stat, row0 + ai * HALF + m * 16, nslots, inv_dim);
#pragma unroll
        for (int bj = 0; bj < 2; ++bj) {
            const ::Route rt = ::route(*F, rmode, u.pn * 2 + bj);
            if (rt.wc0only && wc != 0) continue;
#pragma unroll
            for (int ai = 0; ai < 2; ++ai)
#pragma unroll
                for (int m = 0; m < 4; ++m) {
                    const int row = row0 + ai * HALF + m * 16;
                    f32x4 v0 = acc[ai][bj][m][0] * rs[ai][m], v1 = acc[ai][bj][m][1] * rs[ai][m];
                    if (rt.stat) {
                        float ss = (v0[0] * v0[0] + v0[1] * v0[1]) + (v0[2] * v0[2] + v0[3] * v0[3]) + (v1[0] * v1[0] + v1[1] * v1[1]) + (v1[2] * v1[2] + v1[3] * v1[3]);
                        ss += __shfl_xor(ss, 16); ss += __shfl_xor(ss, 32);
                        if (fq == 0) rt.stat[(size_t)row * 16 + rt.slot + wc] = ss;
                    }
                    if (rt.rope) {
                        const f32x4* csp = (const f32x4*)(F->CS + (size_t)row * 16 + 8 * (fq & 1));
                        const f32x4 c0 = csp[0], c1 = csp[1], c2 = csp[2], c3 = csp[3];
                        f32x4 p0, p1;
#pragma unroll
                        for (int j = 0; j < 4; ++j) { p0[j] = __shfl_xor(v0[j], 32); p1[j] = __shfl_xor(v1[j], 32); }
                        const float sg = fq < 2 ? -1.0f : 1.0f;
                        v0[0] = v0[0] * c0[0] + sg * p0[0] * c0[1]; v0[1] = v0[1] * c0[2] + sg * p0[1] * c0[3]; v0[2] = v0[2] * c1[0] + sg * p0[2] * c1[1]; v0[3] = v0[3] * c1[2] + sg * p0[3] * c1[3];
                        v1[0] = v1[0] * c2[0] + sg * p1[0] * c2[1]; v1[1] = v1[1] * c2[2] + sg * p1[1] * c2[3]; v1[2] = v1[2] * c3[0] + sg * p1[2] * c3[1]; v1[3] = v1[3] * c3[2] + sg * p1[3] * c3[3];
                    }
                    u32x4 w; w.x = cvtpk(v0[0], v0[1]); w.y = cvtpk(v0[2], v0[3]); w.z = cvtpk(v1[0], v1[1]); w.w = cvtpk(v1[2], v1[3]);
                    *(u32x4*)(rt.dst + (size_t)row * rt.pitch + rt.col + wc * 32 + 8 * fq) = w;
                }
        }
    }
};
struct EpiSwiGLU {
    static constexpr bool PERM = true, AFTER_DRAIN = false;
    bf16_t* H; const float* stat; int nslots; float inv_dim;
    __device__ __forceinline__ void operator()(const f32x4 (&acc)[2][2][4][2], const Unit& u, int wr, int wc, int fr, int fq) const {
        const int row0 = u.pm * BM + wr * 64 + fr, col0 = u.pn * 128 + wc * 32 + 8 * fq;
#pragma unroll
        for (int ai = 0; ai < 2; ++ai)
#pragma unroll
            for (int m = 0; m < 4; ++m) {
                const int row = row0 + ai * HALF + m * 16; const float rs = ::row_rstd(stat, row, nslots, inv_dim);
                float hv[8];
#pragma unroll
                for (int n = 0; n < 2; ++n)
#pragma unroll
                    for (int j = 0; j < 4; ++j) { const float g = acc[ai][0][m][n][j] * rs, up = acc[ai][1][m][n][j] * rs;
                        hv[4 * n + j] = g * up * __builtin_amdgcn_rcpf(1.0f + __builtin_amdgcn_exp2f(-g * ::LOG2E)); }
                u32x4 w; w.x = cvtpk(hv[0], hv[1]); w.y = cvtpk(hv[2], hv[3]); w.z = cvtpk(hv[4], hv[5]); w.w = cvtpk(hv[6], hv[7]);
                *(u32x4*)(H + (size_t)row * ::FFH + col0) = w;
            }
    }
};
struct EpiResid {
    static constexpr bool PERM = false, AFTER_DRAIN = false;
    const float* base; float* xout; bf16_t* xn; const bf16_t* xb; float* stat_out;
    __device__ __forceinline__ void operator()(const f32x4 (&acc)[2][2][4][2], const Unit& u, int wr, int wc, int fr, int fq) const {
        typedef unsigned u32x2v __attribute__((ext_vector_type(2)));
        const int row0 = u.pm * BM + wr * 64 + fr, col0 = u.pn * BM + wc * 32 + 4 * fq;
#pragma unroll
        for (int ai = 0; ai < 2; ++ai)
#pragma unroll
            for (int m = 0; m < 4; ++m) {
                const int row = row0 + ai * HALF + m * 16; const size_t ro = (size_t)row * ::DM + col0; float ss = 0.f;
#pragma unroll
                for (int bj = 0; bj < 2; ++bj)
#pragma unroll
                    for (int n = 0; n < 2; ++n) { const size_t o = ro + bj * HALF + n * 16; f32x4 v;
                        if (base) v = *(const f32x4*)(base + o);
                        else { const u32x2v w = *(const u32x2v*)(xb + o); v = (f32x4){__builtin_bit_cast(float, w.x << 16), __builtin_bit_cast(float, w.x & 0xffff0000u), __builtin_bit_cast(float, w.y << 16), __builtin_bit_cast(float, w.y & 0xffff0000u)}; }
                        v = v + acc[ai][bj][m][n];
                        if (xout) *(f32x4*)(xout + o) = v;
                        ss += (v[0] * v[0] + v[1] * v[1]) + (v[2] * v[2] + v[3] * v[3]);
                        if (xn) *(u32x2v*)(xn + o) = (u32x2v){cvtpk(v[0], v[1]), cvtpk(v[2], v[3])}; }
                ss += __shfl_xor(ss, 16); ss += __shfl_xor(ss, 32);
                if (fq == 0) stat_out[(size_t)row * 16 + u.pn * 4 + wc] = ss;
            }
    }
};

template <class Epi, class Sched, bool ALIGN_EPI = false, bool SP2 = false>
__device__ __forceinline__ void gemm_phase(PG8_LAS unsigned char* lds, const Gemm g, const Sched& S, const Epi& E) {
    int tid; asm volatile("v_mov_b32 %0, %1" : "=v"(tid) : "v"(threadIdx.x));
    const int wid = __builtin_amdgcn_readfirstlane(tid >> 6), lane = tid & 63, wr = wid >> 2, wc = wid & 3, fr = lane & 15, fq = lane >> 4;
    const int K = g.K, nt = K / BK;
    unsigned voffA[2], voffB[2];
#pragma unroll
    for (int i = 0; i < 2; ++i) { int R, C; stage_rc(tid * 16 + i * 8192, R, C); const int Rb = Epi::PERM ? ((R & ~31) + perm32(R & 31)) : R;
        voffA[i] = (unsigned)(R * K + C) * 2u; voffB[i] = (unsigned)(Rb * K + C) * 2u; }
    const size_t kstep = (size_t)(BK * 2);
    const size_t hstep = (size_t)HALF * K * 2;
    const size_t tstep = 2 * hstep;
    const unsigned ldsw = (unsigned)wid * 1024u;
    const int aoff = lds_byte(wr * 64 + fr, fq * 8), boff = lds_byte(wc * 32 + fr, fq * 8);
#define PG8_SA(b, h) (((b) * 2 + (h)) * HTB)
#define PG8_SB(b, h) ((4 + (b) * 2 + (h)) * HTB)
#define PG8_STAGE(bufoff, gbase, voff) do { _Pragma("unroll") for (int _i = 0; _i < 2; ++_i) \
        __builtin_amdgcn_global_load_lds((const unsigned*)((const char*)(gbase) + (voff)[_i]), (PG8_LAS unsigned*)(lds + (bufoff) + ldsw + _i * 8192), 16, 0, 0); } while (0)
#define PG8_LDA(dst, b, h) do { _Pragma("unroll") for (int m = 0; m < 4; ++m) _Pragma("unroll") for (int k = 0; k < 2; ++k) dst[m][k] = *(const PG8_LAS bf16x8*)(lds + PG8_SA(b, h) + aoff + m * 2048 + k * 1024); } while (0)
#define PG8_LDB(dst, b, h) do { _Pragma("unroll") for (int n = 0; n < 2; ++n) _Pragma("unroll") for (int k = 0; k < 2; ++k) dst[n][k] = *(const PG8_LAS bf16x8*)(lds + PG8_SB(b, h) + boff + n * 2048 + k * 1024); } while (0)
#define PG8_MMA(ai, bj, At, Bt) do { __builtin_amdgcn_s_setprio(1); _Pragma("unroll") for (int m = 0; m < 4; ++m) _Pragma("unroll") for (int n = 0; n < 2; ++n) _Pragma("unroll") for (int k = 0; k < 2; ++k) \
        acc[ai][bj][m][n] = __builtin_amdgcn_mfma_f32_16x16x32_bf16(Bt[n][k], At[m][k], acc[ai][bj][m][n], 0, 0, 0); __builtin_amdgcn_s_setprio(0); } while (0)
#define PG8_WAIT_V(n) asm volatile("s_waitcnt vmcnt(" #n ")" ::: "memory")
#define PG8_WAIT_L(n) asm volatile("s_waitcnt lgkmcnt(" #n ")" ::: "memory")
#define PG8_BAR __builtin_amdgcn_s_barrier()
#define PG8_SCHED __builtin_amdgcn_sched_barrier(0)
    Unit cur, nxt; int ui = 0;
    if (!S.next(0, cur)) return;
    f32x4 acc[2][2][4][2];
#pragma unroll
    for (int a = 0; a < 2; ++a)
#pragma unroll
        for (int b = 0; b < 2; ++b)
#pragma unroll
            for (int m = 0; m < 4; ++m)
#pragma unroll
                for (int n = 0; n < 2; ++n) acc[a][b][m][n] = (f32x4){0.f, 0.f, 0.f, 0.f};
    bf16x8 At[4][2], B0[2][2], B1[2][2];
    const char* cA = (const char*)g.A + (size_t)cur.pm * tstep; const char* cB = (const char*)g.Bt + (size_t)cur.pn * tstep;
    S.a_ready(cur);
    if constexpr (SP2) {
        PG8_STAGE(PG8_SB(0, 0), cB, voffB); PG8_STAGE(PG8_SB(0, 1), cB + hstep, voffB); PG8_STAGE(PG8_SA(0, 0), cA, voffA); PG8_STAGE(PG8_SA(0, 1), cA + hstep, voffA);
        if (wr == 1) PG8_BAR;
        PG8_WAIT_V(2); PG8_BAR;
        PG8_STAGE(PG8_SB(1, 0), cB + kstep, voffB); PG8_STAGE(PG8_SA(1, 0), cA + kstep, voffA); PG8_STAGE(PG8_SB(1, 1), cB + hstep + kstep, voffB);
        PG8_WAIT_V(6); PG8_BAR;
    } else {
        PG8_STAGE(PG8_SB(0, 0), cB, voffB); PG8_STAGE(PG8_SA(0, 0), cA, voffA); PG8_STAGE(PG8_SB(0, 1), cB + hstep, voffB); PG8_STAGE(PG8_SA(0, 1), cA + hstep, voffA);
        if (wr == 1) PG8_BAR;
        PG8_WAIT_V(4); PG8_BAR;
        PG8_STAGE(PG8_SB(1, 0), cB + kstep, voffB); PG8_STAGE(PG8_SA(1, 0), cA + kstep, voffA); PG8_STAGE(PG8_SB(1, 1), cB + hstep + kstep, voffB);
        PG8_WAIT_V(6); PG8_BAR;
    }
    for (;;) {
        const bool has_next = S.next(ui + 1, nxt);
        const char* nA = has_next ? (const char*)g.A + (size_t)nxt.pm * tstep : cA; const char* nB = has_next ? (const char*)g.Bt + (size_t)nxt.pn * tstep : cB;
        for (int t = 0; t < nt; t += 2) {
            const bool last = (t == nt - 2);
            const char* a1 = cA + (size_t)(t + 1) * kstep;
            const char* a2 = last ? nA : cA + (size_t)(t + 2) * kstep; const char* b2 = last ? nB : cB + (size_t)(t + 2) * kstep;
            const char* a3 = a2 + kstep; const char* b3 = b2 + kstep;
            if (last && has_next) S.a_ready(nxt);
            if constexpr (SP2) {
            PG8_LDB(B0, 0, 0); PG8_LDB(B1, 0, 1); PG8_SCHED; PG8_LDA(At, 0, 0); PG8_STAGE(PG8_SA(1, 1), a1 + hstep, voffA);
            PG8_WAIT_V(8); PG8_WAIT_L(0); PG8_BAR; PG8_MMA(0, 0, At, B0); PG8_MMA(0, 1, At, B1); PG8_BAR; PG8_SCHED;
            PG8_LDA(At, 0, 1); PG8_STAGE(PG8_SB(0, 0), b2, voffB); PG8_STAGE(PG8_SB(0, 1), b2 + hstep, voffB); PG8_STAGE(PG8_SA(0, 0), a2, voffA);
            PG8_WAIT_V(8); PG8_WAIT_L(0); PG8_BAR; PG8_MMA(1, 0, At, B0); PG8_MMA(1, 1, At, B1); PG8_BAR; PG8_SCHED;
            PG8_LDB(B0, 1, 0); PG8_LDB(B1, 1, 1); PG8_SCHED; PG8_LDA(At, 1, 0); PG8_STAGE(PG8_SA(0, 1), a2 + hstep, voffA);
            PG8_WAIT_V(8); PG8_WAIT_L(0); PG8_BAR; PG8_MMA(0, 0, At, B0); PG8_MMA(0, 1, At, B1); PG8_BAR; PG8_SCHED;
            PG8_LDA(At, 1, 1); PG8_STAGE(PG8_SB(1, 0), b3, voffB); PG8_STAGE(PG8_SB(1, 1), b3 + hstep, voffB); PG8_STAGE(PG8_SA(1, 0), a3, voffA);
            PG8_WAIT_V(8); PG8_WAIT_L(0); PG8_BAR; PG8_MMA(1, 0, At, B0); PG8_MMA(1, 1, At, B1); PG8_BAR; PG8_SCHED;
            } else {
            PG8_LDB(B0, 0, 0); PG8_SCHED; PG8_LDA(At, 0, 0); PG8_STAGE(PG8_SA(1, 1), a1 + hstep, voffA);
            PG8_WAIT_L(8); PG8_BAR; PG8_WAIT_L(0); PG8_MMA(0, 0, At, B0); PG8_BAR; PG8_SCHED;
            PG8_LDB(B1, 0, 1); PG8_STAGE(PG8_SB(0, 0), b2, voffB);
            PG8_BAR; PG8_WAIT_L(0); PG8_MMA(0, 1, At, B1); PG8_BAR;
            PG8_LDA(At, 0, 1); PG8_STAGE(PG8_SA(0, 0), a2, voffA);
            PG8_BAR; PG8_WAIT_L(0); PG8_MMA(1, 0, At, B0); PG8_BAR; PG8_SCHED;
            PG8_STAGE(PG8_SB(0, 1), b2 + hstep, voffB);
            PG8_WAIT_V(6); PG8_BAR; PG8_MMA(1, 1, At, B1); PG8_BAR;
            PG8_LDB(B0, 1, 0); PG8_SCHED; PG8_LDA(At, 1, 0); PG8_STAGE(PG8_SA(0, 1), a2 + hstep, voffA);
            PG8_WAIT_L(8); PG8_BAR; PG8_WAIT_L(0); PG8_MMA(0, 0, At, B0); PG8_BAR; PG8_SCHED;
            PG8_LDB(B1, 1, 1); PG8_STAGE(PG8_SB(1, 0), b3, voffB);
            PG8_BAR; PG8_WAIT_L(0); PG8_MMA(0, 1, At, B1); PG8_BAR;
            PG8_LDA(At, 1, 1); PG8_STAGE(PG8_SA(1, 0), a3, voffA);
            PG8_BAR; PG8_WAIT_L(0); PG8_MMA(1, 0, At, B0); PG8_BAR; PG8_SCHED;
            PG8_STAGE(PG8_SB(1, 1), b3 + hstep, voffB);
            PG8_WAIT_V(6); PG8_BAR; PG8_MMA(1, 1, At, B1); PG8_BAR;
            }
        }
        if constexpr (ALIGN_EPI) { if (wr == 0) PG8_BAR; }
        if constexpr (!Epi::AFTER_DRAIN) { E(acc, cur, wr, wc, fr, fq); S.done(cur); }
        if (!has_next) break;
#pragma unroll
        for (int a = 0; a < 2; ++a)
#pragma unroll
            for (int b = 0; b < 2; ++b)
#pragma unroll
                for (int m = 0; m < 4; ++m)
#pragma unroll
                    for (int n = 0; n < 2; ++n) acc[a][b][m][n] = (f32x4){0.f, 0.f, 0.f, 0.f};
        cur = nxt; cA = nA; cB = nB; ++ui;
        if constexpr (ALIGN_EPI) { if (wr == 1) PG8_BAR; }
    }
    PG8_WAIT_V(0);
    if constexpr (!ALIGN_EPI) { if (wr == 0) PG8_BAR; }
    PG8_BAR;
    if constexpr (Epi::AFTER_DRAIN) { E.fused(acc, cur, wr, wc, fr, fq, lds, wid, lane); S.done(cur); }
#undef PG8_SA
#undef PG8_SB
#undef PG8_STAGE
#undef PG8_LDA
#undef PG8_LDB
#undef PG8_MMA
#undef PG8_WAIT_V
#undef PG8_WAIT_L
#undef PG8_BAR
#undef PG8_SCHED
}
}

enum { WM_IN = 0, WM_PLAIN = 1, WM_GATE = 2, WM_UP = 3, WM_MD = 4, WM_UQ = 5, WM_UKV = 6 };
__device__ __forceinline__ int wmap_row(int mode, int n) {
    switch (mode) {
        case WM_GATE: return (n >> 7) * 256 + (n & 127);
        case WM_UP: return (n >> 7) * 256 + 128 + (n & 127);
        case WM_MD: return n < 384 ? n : (n < 640 ? n + 128 : n - 256);
        case WM_UQ: { const int h = n / 96, e = n % 96; return e < 64 ? h * 64 + e : 1024 + h * 32 + (e - 64); }
        case WM_UKV: { const int h = n >> 7, e = n & 127; return e < 64 ? h * 64 + e : 1024 + h * 64 + (e - 64); }
        default: return n;
    }
}
__device__ __forceinline__ float wmap_scale(int mode, int n) {
    if (mode == WM_IN) return (n < 512 || (n >= 1536 && n < 2048)) ? 0.125f * LOG2E : 1.0f;
    if (mode == WM_UQ) return 0.10206207261596577f * LOG2E;
    return 1.0f;
}
struct WJob { const float* W; const float* gain; int K, N; bf16* WT; int mode; };
__device__ __forceinline__ void p0_convert_item(const WJob& w, int item, int lane) {
    const int nblk = (w.N + 63) >> 6, kb = item / nblk, nb = item - kb * nblk, k0 = 64 * kb, n = nb * 64 + lane;
    const bool ok = n < w.N;
    const float* src = w.W + (size_t)k0 * w.N + (ok ? n : 0);
    float v[64];
#pragma unroll
    for (int t = 0; t < 64; ++t) v[t] = src[(size_t)t * w.N];
    if (w.gain) {
#pragma unroll
        for (int t = 0; t < 64; ++t) v[t] *= w.gain[k0 + t];
    }
    const float sc = wmap_scale(w.mode, n);
    if (ok) { bf16* dst = w.WT + (size_t)wmap_row(w.mode, n) * w.K + k0;
#pragma unroll
        for (int c = 0; c < 8; ++c) *(u32x4*)(dst + 8 * c) = (u32x4){cvtpk_g(v[8 * c] * sc, v[8 * c + 1] * sc), cvtpk_g(v[8 * c + 2] * sc, v[8 * c + 3] * sc), cvtpk_g(v[8 * c + 4] * sc, v[8 * c + 5] * sc), cvtpk_g(v[8 * c + 6] * sc, v[8 * c + 7] * sc)}; }
}
__device__ __forceinline__ WJob wjob(const Frame& F, int j) {
    switch (j) {
        case 0: return WJob{F.w_in, F.attn_norm, DM, N0, F.W_IN, WM_IN};
        case 1: return WJob{F.w_out, nullptr, DM, DM, F.W_OUT, WM_PLAIN};
        case 2: return WJob{F.w_gate, F.ffn_norm, DM, FFH, F.W_GU0, WM_GATE};
        case 3: return WJob{F.w_up, F.ffn_norm, DM, FFH, F.W_GU0, WM_UP};
        case 4: return WJob{F.w_down, nullptr, FFH, DM, F.W_DN0, WM_PLAIN};
        case 5: return WJob{F.w_md, F.attn_norm + DM, DM, 672, F.W_MD, WM_MD};
        case 6: return WJob{F.w_uq, F.q_norm, QRANK, NUQ, F.W_UQ, WM_UQ};
        case 7: return WJob{F.w_ukv, F.kv_norm, KVRANK, NUKV, F.W_UKV, WM_UKV};
        case 8: return WJob{F.w_o, nullptr, DM, DM, F.W_O, WM_PLAIN};
        case 9: return WJob{F.w_gate + (size_t)DM * FFH, F.ffn_norm + DM, DM, FFH, F.W_GU1, WM_GATE};
        case 10: return WJob{F.w_up + (size_t)DM * FFH, F.ffn_norm + DM, DM, FFH, F.W_GU1, WM_UP};
        default: return WJob{F.w_down + (size_t)FFH * DM, nullptr, FFH, DM, F.W_DN1, WM_PLAIN};
    }
}
__device__ __forceinline__ void p0_prologue(const Frame& F, LAS unsigned char* lds) {
    const int gw = F.bid * NWAVES + F.wave, NGW = F.G * NWAVES;
    { int it = gw, base = 0;
#pragma unroll
      for (int j = 0; j < 12; ++j) { const WJob w = wjob(F, j); const int end = base + (w.K / 64) * ((w.N + 63) / 64);
          for (; it < end; it += NGW) p0_convert_item(w, it - base, F.lane);
          base = end; } }
    for (int i = gw * 64 + F.lane; i < 96 * DM / 8; i += NGW * 64) *(u32x4*)(F.W_MD + (size_t)416 * DM + (size_t)i * 8) = (u32x4){0u, 0u, 0u, 0u};
    for (int m = gw; m < M; m += NGW) {
        const f32x4* xr = (const f32x4*)(F.x + (size_t)m * DM) + F.lane; f32x4 v[4]; float s = 0.f;
#pragma unroll
        for (int j = 0; j < 4; ++j) { v[j] = xr[64 * j]; s += (v[j].x * v[j].x + v[j].y * v[j].y) + (v[j].z * v[j].z + v[j].w * v[j].w); }
        s = wave_sum(s);
        u32x2* o8 = (u32x2*)(F.XN + (size_t)m * DM) + F.lane;
#pragma unroll
        for (int j = 0; j < 4; ++j) o8[64 * j] = (u32x2){cvtpk_g(v[j].x, v[j].y), cvtpk_g(v[j].z, v[j].w)};
        if (F.lane < 16) F.ST[(size_t)m * 16 + F.lane] = F.lane == 0 ? s : 0.f;
    }
    { f32x4* z = (f32x4*)(F.ST + (size_t)M * 16); const int n4 = 6 * M * 16 / 4;
      for (int i = gw * 64 + F.lane; i < n4; i += NGW * 64) z[i] = (f32x4){0.f, 0.f, 0.f, 0.f}; }
    for (int e = gw * 64 + F.lane; e < M * 16; e += NGW * 64) {
        const int row = e >> 4, i = e & 15;
        const float freq = exp2f(-(float)i * 0.83048202372184059f);
        const float ang = (float)F.pos[row] * freq;
        const float nrev = rintf(ang * 0.15915494309189535f);
        float r = fmaf(-nrev, 6.28125f, ang); r = fmaf(-nrev, 0.0019353071795864769f, r);
        const float rf = r * 0.15915494309189535f;
        F.CS[e] = (f32x2){__builtin_amdgcn_cosf(rf), __builtin_amdgcn_sinf(rf)};
    }
}

enum { G_ROWSCALE = 0, G_SWIGLU = 1, G_RESID = 2 };
struct GemmDesc { const bf16* A; const bf16* Bt; int N, K; int kind; int rmode; const float* stat; int nslots; float inv_dim; const float* base; float* xout; bf16* xn; float* stat_out; bf16* hout; };

__device__ __forceinline__ void naive_gemm_phase(const Frame& F, const GemmDesc g) {
    const int lane = F.lane, fr = lane & 15, fq = lane >> 4;
    const int gw = F.bid * NWAVES + F.wave, NGW = F.G * NWAVES;
    const int K = g.K;
    if (g.kind == G_SWIGLU) {
        const int ncb = FFH / 32, units = (M / 32) * ncb;
        for (int u = gw; u < units; u += NGW) {
            const int r0 = (u / ncb) * 32, j0 = (u % ncb) * 32;
            const int brow = (j0 >> 7) * 256 + (j0 & 127);
            f32x4 ag[2][2], au[2][2];
#pragma unroll
            for (int a = 0; a < 2; ++a)
#pragma unroll
                for (int b = 0; b < 2; ++b) { ag[a][b] = (f32x4){0.f, 0.f, 0.f, 0.f}; au[a][b] = (f32x4){0.f, 0.f, 0.f, 0.f}; }
            for (int k0 = 0; k0 < K; k0 += 32) {
                bf16x8 af[2], bg[2], bu[2];
#pragma unroll
                for (int a = 0; a < 2; ++a) af[a] = *(const bf16x8*)(g.A + (size_t)(r0 + 16 * a + fr) * K + k0 + 8 * fq);
#pragma unroll
                for (int b = 0; b < 2; ++b) { bg[b] = *(const bf16x8*)(g.Bt + (size_t)(brow + 16 * b + fr) * K + k0 + 8 * fq); bu[b] = *(const bf16x8*)(g.Bt + (size_t)(brow + 128 + 16 * b + fr) * K + k0 + 8 * fq); }
#pragma unroll
                for (int a = 0; a < 2; ++a)
#pragma unroll
                    for (int b = 0; b < 2; ++b) { ag[a][b] = __builtin_amdgcn_mfma_f32_16x16x32_bf16(af[a], bg[b], ag[a][b], 0, 0, 0); au[a][b] = __builtin_amdgcn_mfma_f32_16x16x32_bf16(af[a], bu[b], au[a][b], 0, 0, 0); }
            }
#pragma unroll
            for (int a = 0; a < 2; ++a)
#pragma unroll
                for (int r = 0; r < 4; ++r) { const int row = r0 + 16 * a + 4 * fq + r; const float rs = row_rstd(g.stat, row, g.nslots, g.inv_dim);
#pragma unroll
                    for (int b = 0; b < 2; ++b) { const float gv = ag[a][b][r] * rs, uv = au[a][b][r] * rs; const float hv = gv * uv / (1.0f + __builtin_amdgcn_exp2f(-gv * LOG2E));
                        g.hout[(size_t)row * FFH + j0 + 16 * b + fr] = (bf16)f2bf(hv); } }
        }
        return;
    }
    const int ncb = g.N / 64, units = (M / 32) * ncb;
    for (int u = gw; u < units; u += NGW) {
        const int r0 = (u / ncb) * 32, c0 = (u % ncb) * 64;
        f32x4 acc[2][4];
#pragma unroll
        for (int a = 0; a < 2; ++a)
#pragma unroll
            for (int b = 0; b < 4; ++b) acc[a][b] = (f32x4){0.f, 0.f, 0.f, 0.f};
        for (int k0 = 0; k0 < K; k0 += 32) {
            bf16x8 af[2], bfr[4];
#pragma unroll
            for (int a = 0; a < 2; ++a) af[a] = *(const bf16x8*)(g.A + (size_t)(r0 + 16 * a + fr) * K + k0 + 8 * fq);
#pragma unroll
            for (int b = 0; b < 4; ++b) bfr[b] = *(const bf16x8*)(g.Bt + (size_t)(c0 + 16 * b + fr) * K + k0 + 8 * fq);
#pragma unroll
            for (int a = 0; a < 2; ++a)
#pragma unroll
                for (int b = 0; b < 4; ++b) acc[a][b] = __builtin_amdgcn_mfma_f32_16x16x32_bf16(af[a], bfr[b], acc[a][b], 0, 0, 0);
        }
        if (g.kind == G_RESID) {
#pragma unroll
            for (int a = 0; a < 2; ++a)
#pragma unroll
                for (int r = 0; r < 4; ++r) { const int row = r0 + 16 * a + 4 * fq + r; float ss = 0.f;
#pragma unroll
                    for (int b = 0; b < 4; ++b) { const int col = c0 + 16 * b + fr; const size_t o = (size_t)row * DM + col; const float v = (g.base ? g.base[o] : bf2f(F.XN[o])) + acc[a][b][r]; if (g.xout) g.xout[o] = v; if (g.xn) g.xn[o] = (bf16)f2bf(v); ss += v * v; }
                    ss += __shfl_xor(ss, 1); ss += __shfl_xor(ss, 2); ss += __shfl_xor(ss, 4); ss += __shfl_xor(ss, 8);
                    if (fr == 0) atomicAdd(g.stat_out + (size_t)row * 16, ss); }
        } else {
            const int hh = c0 >> 7; const Route rt = route(F, g.rmode, hh); const int cin = c0 & 127;
            if (rt.wc0only && cin != 0) continue;
#pragma unroll
            for (int a = 0; a < 2; ++a)
#pragma unroll
                for (int r = 0; r < 4; ++r) { const int row = r0 + 16 * a + 4 * fq + r; const float rs = row_rstd(g.stat, row, g.nslots, g.inv_dim);
                    float v[4]; float ss = 0.f;
#pragma unroll
                    for (int b = 0; b < 4; ++b) { v[b] = acc[a][b][r] * rs; ss += v[b] * v[b]; }
                    if (rt.rope) { const f32x2 cs = F.CS[(size_t)row * 16 + fr];
#pragma unroll
                        for (int p = 0; p < 2; ++p) { const float x1 = v[2 * p], x2 = v[2 * p + 1]; v[2 * p] = x1 * cs.x - x2 * cs.y; v[2 * p + 1] = x2 * cs.x + x1 * cs.y; } }
#pragma unroll
                    for (int b = 0; b < 4; ++b) { if (rt.wc0only && b >= 2) break; rt.dst[(size_t)row * rt.pitch + rt.col + cin + 16 * b + fr] = (bf16)f2bf(v[b]); }
                    if (rt.stat) { ss += __shfl_xor(ss, 1); ss += __shfl_xor(ss, 2); ss += __shfl_xor(ss, 4); ss += __shfl_xor(ss, 8); if (fr == 0) atomicAdd(rt.stat + (size_t)row * 16, ss); } }
        }
    }
}

__device__ __forceinline__ float dot8(const float* q, const u32x4 c) {
    return q[0] * __builtin_bit_cast(float, c.x << 16) + q[1] * __builtin_bit_cast(float, c.x & 0xffff0000u) + q[2] * __builtin_bit_cast(float, c.y << 16) + q[3] * __builtin_bit_cast(float, c.y & 0xffff0000u)
         + q[4] * __builtin_bit_cast(float, c.z << 16) + q[5] * __builtin_bit_cast(float, c.z & 0xffff0000u) + q[6] * __builtin_bit_cast(float, c.w << 16) + q[7] * __builtin_bit_cast(float, c.w & 0xffff0000u);
}
__device__ __forceinline__ void axpy8(float* o, float al, float p, const u32x4 c) {
    o[0] = o[0] * al + p * __builtin_bit_cast(float, c.x << 16); o[1] = o[1] * al + p * __builtin_bit_cast(float, c.x & 0xffff0000u);
    o[2] = o[2] * al + p * __builtin_bit_cast(float, c.y << 16); o[3] = o[3] * al + p * __builtin_bit_cast(float, c.y & 0xffff0000u);
    o[4] = o[4] * al + p * __builtin_bit_cast(float, c.z << 16); o[5] = o[5] * al + p * __builtin_bit_cast(float, c.z & 0xffff0000u);
    o[6] = o[6] * al + p * __builtin_bit_cast(float, c.w << 16); o[7] = o[7] * al + p * __builtin_bit_cast(float, c.w & 0xffff0000u);
}
__device__ __forceinline__ void naive_sb(const Frame& F) {
    const int gw = F.bid * NWAVES + F.wave, NGW = F.G * NWAVES;
    for (int u = gw; u < BATCH * 8 * (SEQ / 64); u += NGW) {
        const int blk = u % (SEQ / 64), h = (u / (SEQ / 64)) % 8, b = u / (SEQ / 64 * 8);
        const int t = blk * 64 + F.lane; const size_t rowq = (size_t)b * SEQ + t;
        float q[64], o[64];
#pragma unroll
        for (int d = 0; d < 64; ++d) { q[d] = bf2f(F.QKV0[rowq * N0 + h * 64 + d]); o[d] = 0.f; }
        float carry = 0.f;
        for (int s = blk * 64 + 63; s >= 0; --s) {
            const bf16* kr = F.QKV0 + ((size_t)b * SEQ + s) * N0 + 512 + h * 64; const bf16* vr = kr + 512;
            float y = 0.f;
#pragma unroll
            for (int d = 0; d < 8; ++d) y += dot8(q + 8 * d, ((const u32x4*)kr)[d]);
            const bool valid = s < t;
            const float sp = fmaxf(y, 0.f) + __builtin_amdgcn_logf(1.0f + __builtin_amdgcn_exp2f(-fabsf(y)));
            const float w = valid ? __builtin_amdgcn_exp2f((y - sp) + carry) : 0.f;
            if (valid) carry -= sp;
#pragma unroll
            for (int d = 0; d < 8; ++d) axpy8(o + 8 * d, 1.0f, w, ((const u32x4*)vr)[d]);
        }
#pragma unroll
        for (int d = 0; d < 64; ++d) F.AO[rowq * DM + h * 64 + d] = (bf16)f2bf(o[d]);
    }
}
__device__ __forceinline__ float t5_bias2(const Frame& F, int rel, int h) {
    int bk = rel;
    if (rel >= 16) { bk = 16 + (int)(log2f((float)rel * 0.0625f) * (16.0f / 3.0f)); bk = bk > 31 ? 31 : bk; }
    return F.relb[bk * 8 + h] * LOG2E;
}
__device__ __forceinline__ void naive_swa(const Frame& F) {
    const int gw = F.bid * NWAVES + F.wave, NGW = F.G * NWAVES;
    for (int u = gw; u < BATCH * 8 * (SEQ / 64); u += NGW) {
        const int blk = u % (SEQ / 64), h = (u / (SEQ / 64)) % 8, b = u / (SEQ / 64 * 8), kvh = h >> 2;
        const int t = blk * 64 + F.lane; const size_t rowq = (size_t)b * SEQ + t;
        float q[64], o[64];
#pragma unroll
        for (int d = 0; d < 64; ++d) { q[d] = bf2f(F.QKV0[rowq * N0 + 1536 + h * 64 + d]); o[d] = 0.f; }
        float m = F.sinks[h] * LOG2E, l = 1.0f;
        const int s_lo = blk * 64 - 127 < 0 ? 0 : blk * 64 - 127;
        for (int s = s_lo; s <= blk * 64 + 63; ++s) {
            const bf16* kr = F.QKV0 + ((size_t)b * SEQ + s) * N0 + 2048 + kvh * 64; const bf16* vr = kr + 128;
            float y = 0.f;
#pragma unroll
            for (int d = 0; d < 8; ++d) y += dot8(q + 8 * d, ((const u32x4*)kr)[d]);
            const int rel = t - s; const bool valid = rel >= 0 && rel < 128;
            const float lg = valid ? y + t5_bias2(F, rel & 127, h) : -INFINITY;
            const float mn = fmaxf(m, lg), al = __builtin_amdgcn_exp2f(m - mn), p = __builtin_amdgcn_exp2f(lg - mn);
            l = l * al + p; m = mn;
#pragma unroll
            for (int d = 0; d < 8; ++d) axpy8(o + 8 * d, al, p, ((const u32x4*)vr)[d]);
        }
        const float il = 1.0f / l;
#pragma unroll
        for (int d = 0; d < 64; ++d) F.AO[rowq * DM + 512 + h * 64 + d] = (bf16)f2bf(o[d] * il);
    }
}
__device__ __forceinline__ void naive_mla(const Frame& F) {
    const int gw = F.bid * NWAVES + F.wave, NGW = F.G * NWAVES;
    for (int u = gw; u < BATCH * 16 * (SEQ / 64); u += NGW) {
        const int blk = (SEQ / 64 - 1) - u % (SEQ / 64), h = (u / (SEQ / 64)) % 16, b = u / (SEQ / 64 * 16);
        const int t = blk * 64 + F.lane; const size_t rowq = (size_t)b * SEQ + t;
        float q[96], o[64];
#pragma unroll
        for (int d = 0; d < 64; ++d) { q[d] = bf2f(F.QN[rowq * 1024 + h * 64 + d]); o[d] = 0.f; }
#pragma unroll
        for (int d = 0; d < 32; ++d) q[64 + d] = bf2f(F.QR[rowq * 512 + h * 32 + d]);
        float m = -1e30f, l = 0.f;
        for (int s = 0; s <= blk * 64 + 63; ++s) {
            const size_t rk = (size_t)b * SEQ + s; const bf16* kn = F.KN + rk * 1024 + h * 64; const bf16* kr = F.KR + rk * 32; const bf16* vr = F.VV + rk * 1024 + h * 64;
            float y = 0.f;
#pragma unroll
            for (int d = 0; d < 8; ++d) y += dot8(q + 8 * d, ((const u32x4*)kn)[d]);
#pragma unroll
            for (int d = 0; d < 4; ++d) y += dot8(q + 64 + 8 * d, ((const u32x4*)kr)[d]);
            const float lg = s <= t ? y : -INFINITY;
            const float mn = fmaxf(m, lg), al = __builtin_amdgcn_exp2f(m - mn), p = __builtin_amdgcn_exp2f(lg - mn);
            l = l * al + p; m = mn;
#pragma unroll
            for (int d = 0; d < 8; ++d) axpy8(o + 8 * d, al, p, ((const u32x4*)vr)[d]);
        }
        const float il = 1.0f / l;
#pragma unroll
        for (int d = 0; d < 64; ++d) F.AO[rowq * DM + h * 64 + d] = (bf16)f2bf(o[d] * il);
    }
}
__device__ __forceinline__ void final_norm_phase(const Frame& F) {
    const int gw = F.bid * NWAVES + F.wave, NGW = F.G * NWAVES;
    for (int m = gw; m < M; m += NGW) {
        const float rs = row_rstd(F.ST + (size_t)4 * M * 16, m, 16, 1.0f / DM);
        f32x4* xr = (f32x4*)(F.out + (size_t)m * DM) + F.lane; const f32x4* gr = (const f32x4*)F.final_norm + F.lane;
#pragma unroll
        for (int j = 0; j < 4; ++j) { const f32x4 v = xr[64 * j], g = gr[64 * j]; xr[64 * j] = v * rs * g; }
    }
}

namespace att {
typedef float f32x16 __attribute__((ext_vector_type(16)));
typedef short v4i16_t __attribute__((ext_vector_type(4)));
typedef __bf16 bf16x2_t __attribute__((ext_vector_type(2)));
constexpr int NSLOT = 3, SLOT_K = 12288, SLOT_V = 8192, OFF_K = 0, OFF_V = NSLOT * SLOT_K, OFF_FLAG = OFF_V + NSLOT * SLOT_V, OFF_TB = OFF_FLAG + 64, ATT_LDS = OFF_TB + 512;
__device__ __forceinline__ unsigned cvtpk(float lo, float hi) { f32x2 v = {lo, hi}; bf16x2_t b = __builtin_convertvector(v, bf16x2_t); return __builtin_bit_cast(unsigned, b); }
__device__ __forceinline__ void glds16(const void* gsrc, unsigned lds_dst) { unsigned keep;
    asm volatile("s_mov_b32 %0, m0\n\ts_mov_b32 m0, %2\n\ts_nop 0\n\tglobal_load_lds_dwordx4 %1, off\n\ts_mov_b32 m0, %0" : "=&s"(keep) : "v"(gsrc), "s"(lds_dst) : "memory"); }
#define ATT_WAIT_BAR(N) asm volatile("s_waitcnt vmcnt(" #N ") lgkmcnt(0)\n\ts_barrier" ::: "memory")
__device__ __forceinline__ int crow(int r, int hi) { return (r & 3) + 8 * (r >> 2) + 4 * hi; }

template <int MODE> __device__ __forceinline__ void attn_unit(const Frame& F, LAS unsigned char* lds, int b, int h, int qb) {
    const int tid = F.tid, lane = F.lane, wid = F.wave, r32 = lane & 31, hi = lane >> 5;
    constexpr int ND2 = MODE == 2 ? 6 : 4;
    const int q0 = qb * 256, qw0 = q0 + 32 * wid, qg = qw0 + r32;
    const size_t rowq = (size_t)b * SEQ + qg, rowb = (size_t)b * SEQ;
    const bf16 *Qp, *Qr = nullptr, *Kb, *Vb, *KRb = nullptr; int pK, pV; bf16* Op;
    if (MODE == 0) { Qp = F.QKV0 + rowq * N0 + h * 64; Kb = F.QKV0 + rowb * N0 + 512 + h * 64; Vb = Kb + 512; pK = pV = N0; Op = F.AO + rowq * DM + h * 64; }
    else if (MODE == 1) { Qp = F.QKV0 + rowq * N0 + 1536 + h * 64; Kb = F.QKV0 + rowb * N0 + 2048 + (h >> 2) * 64; Vb = Kb + 128; pK = pV = N0; Op = F.AO + rowq * DM + 512 + h * 64; }
    else { Qp = F.QN + rowq * 1024 + h * 64; Qr = F.QR + rowq * 512 + h * 32; Kb = F.KN + rowb * 1024 + h * 64; KRb = F.KR + rowb * 32; Vb = F.VV + rowb * 1024 + h * 64; pK = pV = 1024; Op = F.AO + rowq * DM + h * 64; }
    int t_first, t_step, NT;
    if (MODE == 0) { t_first = q0 / 64 + 3; t_step = -1; NT = q0 / 64 + 4; }
    else if (MODE == 1) { const int tlo = q0 / 64 - 2 < 0 ? 0 : q0 / 64 - 2; t_first = tlo; t_step = 1; NT = q0 / 64 + 4 - tlo; }
    else { t_first = 0; t_step = 1; NT = q0 / 64 + 4; }
    const bf16* ksrc = Kb + (size_t)lane * pK + wid * 8;
    const bf16* krsrc = MODE == 2 ? KRb + (size_t)lane * 32 + (wid & 3) * 8 : nullptr;
    const bf16* vsrc = Vb + (size_t)(16 * (wid & 3) + (lane >> 2)) * pV + (wid >> 2) * 32 + (lane & 3) * 8;
    const unsigned lds0 = (unsigned)(uintptr_t)lds;
#define ATT_ISSUE(ti, slot) do { const int kb_ = 64 * (ti); const unsigned so_ = (unsigned)(slot); \
        glds16(ksrc + (size_t)kb_ * pK, (unsigned)__builtin_amdgcn_readfirstlane(lds0 + OFF_K + so_ * SLOT_K + wid * 1024)); \
        if (MODE == 2 && wid < 4) glds16(krsrc + (size_t)kb_ * 32, (unsigned)__builtin_amdgcn_readfirstlane(lds0 + OFF_K + so_ * SLOT_K + (8 + wid) * 1024)); \
        glds16(vsrc + (size_t)kb_ * pV, (unsigned)__builtin_amdgcn_readfirstlane(lds0 + OFF_V + so_ * SLOT_V + wid * 1024)); } while (0)
    ATT_ISSUE(t_first, 0);
    if (NT > 1) ATT_ISSUE(t_first + t_step, 1);
    bf16x8 qr[ND2];
#pragma unroll
    for (int c2 = 0; c2 < 4; ++c2) qr[c2] = *(const bf16x8*)(Qp + 16 * c2 + 8 * hi);
    if (MODE == 2) { qr[ND2 - 2] = *(const bf16x8*)(Qr + 8 * hi); qr[ND2 - 1] = *(const bf16x8*)(Qr + 16 + 8 * hi); }
    LAS float* tb = (LAS float*)(lds + OFF_TB);
    volatile LAS unsigned* flg = (volatile LAS unsigned*)(lds + OFF_FLAG);
    if (MODE == 1 && tid < 128) tb[tid] = t5_bias2(F, tid, h);
    f32x16 o[2]; o[0] = f32x16{}; o[1] = f32x16{};
    float m_run = MODE == 1 ? F.sinks[h] * LOG2E : -1e30f, l_run = (MODE == 1 && hi == 0) ? 1.0f : 0.0f, C = 1.0f;
    const LAS unsigned char* kp0 = lds + OFF_K + hi * 1024 + r32 * 16;
    const LAS unsigned char* vp0 = lds + OFF_V + ((lane >> 4) & 1) * 32 + (lane & 3) * 8 + (4 * hi + ((lane & 15) >> 2)) * 64;
    int slot = 0;
    for (int i = 0; i < NT; ++i) {
        if (i == 0 || i + 1 >= NT) ATT_WAIT_BAR(0);
        else if (MODE == 2 && wid < 4) ATT_WAIT_BAR(3);
        else ATT_WAIT_BAR(2);
        if (MODE == 0 && i > 0) { const LAS unsigned* fp = (const LAS unsigned*)(lds + OFF_FLAG) + ((i - 1) & 1) * 8; unsigned a = 1u;
#pragma unroll
            for (int w = 0; w < 8; ++w) a &= fp[w];
            if (__builtin_amdgcn_readfirstlane(a)) break; }
        if (i + 2 < NT) ATT_ISSUE(t_first + (i + 2) * t_step, slot == 0 ? 2 : slot - 1);
        const int kb = 64 * (t_first + i * t_step);
        bool skip, need_mask;
        if (MODE == 0) { skip = kb >= qw0 + 31; need_mask = kb + 63 >= qw0; }
        else if (MODE == 1) { skip = kb > qw0 + 31 || kb + 63 < qw0 - 127; need_mask = true; }
        else { skip = kb > qw0 + 31; need_mask = kb + 63 > qw0; }
        if (!skip) {
            f32x16 s0 = f32x16{}, s1 = f32x16{};
            const LAS unsigned char* kp = kp0 + slot * SLOT_K;
#pragma unroll
            for (int c2 = 0; c2 < ND2; ++c2) {
                const bf16x8 k0 = *(const LAS bf16x8*)(kp + c2 * 2048), k1 = *(const LAS bf16x8*)(kp + c2 * 2048 + 512);
                s0 = __builtin_amdgcn_mfma_f32_32x32x16_bf16(k0, qr[c2], s0, 0, 0, 0);
                s1 = __builtin_amdgcn_mfma_f32_32x32x16_bf16(k1, qr[c2], s1, 0, 0, 0);
            }
            u32x4 pw[4];
            if (MODE == 0) {
                float om[32], be[32];
#pragma unroll
                for (int r = 0; r < 16; ++r) {
                    { const float e = __builtin_amdgcn_exp2f(fminf(s0[r], 64.0f)), d = __builtin_amdgcn_rcpf(1.0f + e); om[r] = d; be[r] = e * d; }
                    { const float e = __builtin_amdgcn_exp2f(fminf(s1[r], 64.0f)), d = __builtin_amdgcn_rcpf(1.0f + e); om[16 + r] = d; be[16 + r] = e * d; }
                }
                if (need_mask) {
#pragma unroll
                    for (int r = 0; r < 16; ++r) { const int key = kb + crow(r, hi);
                        if (key >= qg) { om[r] = 1.0f; be[r] = 0.0f; }
                        if (key + 32 >= qg) { om[16 + r] = 1.0f; be[16 + r] = 0.0f; } }
                }
                float ga[8], gb[8];
#pragma unroll
                for (int gi = 0; gi < 8; ++gi) { const float gp = (om[4 * gi] * om[4 * gi + 1]) * (om[4 * gi + 2] * om[4 * gi + 3]);
                    const auto rr = __builtin_amdgcn_permlane32_swap(__float_as_uint(gp), __float_as_uint(gp), false, false); ga[gi] = __uint_as_float(rr[0]); gb[gi] = __uint_as_float(rr[1]); }
                float R = C, Rm[8];
#pragma unroll
                for (int gi = 7; gi >= 0; --gi) { const float Rb = R; R *= gb[gi]; const float Ra = R; R *= ga[gi]; Rm[gi] = hi ? Rb : Ra; }
                C = R;
#pragma unroll
                for (int gi = 0; gi < 8; ++gi) { float P = Rm[gi];
                    be[4 * gi + 3] *= P; P *= om[4 * gi + 3]; be[4 * gi + 2] *= P; P *= om[4 * gi + 2]; be[4 * gi + 1] *= P; P *= om[4 * gi + 1]; be[4 * gi] *= P; }
#pragma unroll
                for (int k = 0; k < 4; ++k) pw[k] = (u32x4){cvtpk(be[8 * k], be[8 * k + 1]), cvtpk(be[8 * k + 2], be[8 * k + 3]), cvtpk(be[8 * k + 4], be[8 * k + 5]), cvtpk(be[8 * k + 6], be[8 * k + 7])};
            } else {
                if (MODE == 1) {
#pragma unroll
                    for (int r = 0; r < 16; ++r) { const int rel = qg - (kb + crow(r, hi));
                        s0[r] = (rel >= 0 && rel < 128) ? s0[r] + tb[rel & 127] : -INFINITY;
                        s1[r] = (rel - 32 >= 0 && rel - 32 < 128) ? s1[r] + tb[(rel - 32) & 127] : -INFINITY; }
                } else if (need_mask) {
#pragma unroll
                    for (int r = 0; r < 16; ++r) { const int key = kb + crow(r, hi); if (key > qg) s0[r] = -INFINITY; if (key + 32 > qg) s1[r] = -INFINITY; }
                }
                float mx = fmaxf(s0[0], s1[0]);
#pragma unroll
                for (int r = 1; r < 16; ++r) mx = fmaxf(mx, fmaxf(s0[r], s1[r]));
                { const auto rr = __builtin_amdgcn_permlane32_swap(__float_as_uint(mx), __float_as_uint(mx), false, false); mx = fmaxf(__uint_as_float(rr[0]), __uint_as_float(rr[1])); }
                const float mn = fmaxf(m_run, mx);
                if (__any(mn > m_run)) { const float al = __builtin_amdgcn_exp2f(m_run - mn); l_run *= al; m_run = mn;
#pragma unroll
                    for (int r = 0; r < 16; ++r) { o[0][r] *= al; o[1][r] *= al; } }
                float ls = 0.f;
#pragma unroll
                for (int r = 0; r < 16; ++r) { s0[r] = __builtin_amdgcn_exp2f(s0[r] - m_run); s1[r] = __builtin_amdgcn_exp2f(s1[r] - m_run); ls += s0[r] + s1[r]; }
                l_run += ls;
                pw[0] = (u32x4){cvtpk(s0[0], s0[1]), cvtpk(s0[2], s0[3]), cvtpk(s0[4], s0[5]), cvtpk(s0[6], s0[7])};
                pw[1] = (u32x4){cvtpk(s0[8], s0[9]), cvtpk(s0[10], s0[11]), cvtpk(s0[12], s0[13]), cvtpk(s0[14], s0[15])};
                pw[2] = (u32x4){cvtpk(s1[0], s1[1]), cvtpk(s1[2], s1[3]), cvtpk(s1[4], s1[5]), cvtpk(s1[6], s1[7])};
                pw[3] = (u32x4){cvtpk(s1[8], s1[9]), cvtpk(s1[10], s1[11]), cvtpk(s1[12], s1[13]), cvtpk(s1[14], s1[15])};
            }
            const LAS unsigned char* vp = vp0 + slot * SLOT_V;
#pragma unroll
            for (int dh = 0; dh < 2; ++dh)
#pragma unroll
                for (int ks = 0; ks < 4; ++ks) {
                    const v4i16_t lo = __builtin_amdgcn_ds_read_tr16_b64_v4i16((LAS v4i16_t*)(vp + dh * 4096 + ks * 1024));
                    const v4i16_t hi4 = __builtin_amdgcn_ds_read_tr16_b64_v4i16((LAS v4i16_t*)(vp + dh * 4096 + ks * 1024 + 512));
                    const bf16x8 vf = (bf16x8){lo[0], lo[1], lo[2], lo[3], hi4[0], hi4[1], hi4[2], hi4[3]};
                    o[dh] = __builtin_amdgcn_mfma_f32_32x32x16_bf16(vf, __builtin_bit_cast(bf16x8, pw[ks]), o[dh], 0, 0, 0);
                }
        }
        if (MODE == 0) { const unsigned small = __all(C < 1.17549435e-38f) ? 1u : 0u; if (lane == 0) flg[(i & 1) * 8 + wid] = small; }
        slot = slot == 2 ? 0 : slot + 1;
    }
    float sc = 1.0f;
    if (MODE != 0) { const auto rr = __builtin_amdgcn_permlane32_swap(__float_as_uint(l_run), __float_as_uint(l_run), false, false); sc = 1.0f / (__uint_as_float(rr[0]) + __uint_as_float(rr[1])); }
#pragma unroll
    for (int dh = 0; dh < 2; ++dh)
#pragma unroll
        for (int g = 0; g < 4; ++g)
            *(u32x2*)(Op + 32 * dh + 8 * g + 4 * hi) = (u32x2){cvtpk(o[dh][4 * g] * sc, o[dh][4 * g + 1] * sc), cvtpk(o[dh][4 * g + 2] * sc, o[dh][4 * g + 3] * sc)};
    ATT_WAIT_BAR(0);
#undef ATT_ISSUE
}
__device__ __forceinline__ void attn0_phase(const Frame& F, LAS unsigned char* lds) {
    const int vcu = (F.G % 8 == 0) ? (F.bid % 8) * (F.G / 8) + F.bid / 8 : F.bid;
    for (int p = vcu; p < 256; p += F.G) { const int bh = p >> 3, s = p & 7, b = bh >> 3, h = bh & 7;
#if USE_FAST_SB
        for (int k = 0; k < 2; ++k) attn_unit<0>(F, lds, b, h, k ? s : 15 - s);
#endif
#if USE_FAST_SWA
        for (int k = 0; k < 2; ++k) attn_unit<1>(F, lds, b, h, k ? s : 15 - s);
#endif
    }
}
__device__ __forceinline__ void attn1_phase(const Frame& F, LAS unsigned char* lds) {
    const int vcu = (F.G % 8 == 0) ? (F.bid % 8) * (F.G / 8) + F.bid / 8 : F.bid;
    for (int p = vcu; p < 256; p += F.G) { const int bh = p >> 2, s = p & 3, b = bh >> 4, h = bh & 15;
        for (int k = 0; k < 4; ++k) attn_unit<2>(F, lds, b, h, k == 0 ? 15 - s : (k == 1 ? 11 - s : (k == 2 ? 4 + s : s))); }
}
}

#define RLX_AGENT __ATOMIC_RELAXED, __HIP_MEMORY_SCOPE_AGENT
#define XB_TMO      128
#define XB_XCNT(j)  (256  + 64 * (j))
#define XB_XSUB(j)  (1280 + 64 * (j))
#define XB_XGEN(j)  (2304 + 64 * (j))
#define XB_TOP      3328
#define XB_TOPGEN   3392
#define XCD_BAR_WORDS 3456
#define XB_SPIN_CAP (1u << 22)
__device__ __forceinline__ unsigned xb_ld(unsigned* p)              { return __hip_atomic_load(p, __ATOMIC_RELAXED, __HIP_MEMORY_SCOPE_AGENT); }
__device__ __forceinline__ unsigned xb_add(unsigned* p, unsigned v) { return __hip_atomic_fetch_add(p, v, __ATOMIC_RELAXED, __HIP_MEMORY_SCOPE_AGENT); }
__device__ __forceinline__ unsigned xb_xcc_id() { return (unsigned)__builtin_amdgcn_s_getreg((3 << 11) | 20) & 0xFu; }
#define XB_SPIN(cond, bar) do { unsigned _sp = 0; while (cond) { __builtin_amdgcn_s_sleep(1); \
    if ((++_sp & 255u) == 0u) { if (xb_ld(&(bar)[XB_TMO])) break; if (_sp > XB_SPIN_CAP) { atomicAdd(&(bar)[XB_TMO], 1u); break; } } } } while (0)
struct XcdBarrier { unsigned* bar; unsigned x; volatile LAS unsigned* st; };
__device__ __forceinline__ XcdBarrier xcd_barrier_post(unsigned* bar, volatile LAS unsigned* st) {
    XcdBarrier b; b.bar = bar; b.x = xb_xcc_id(); b.st = st;
    if (threadIdx.x == 0) (void)xb_add(&bar[XB_XCNT(b.x)], 1u);
    return b;
}
__device__ __forceinline__ void xcd_barrier_complete(unsigned* bar, unsigned x, unsigned& nloc, unsigned& nx) {
    const unsigned G = gridDim.x * gridDim.y * gridDim.z;
    unsigned sum, cnt, mine, sp = 0u;
    for (;;) {
        sum = 0u; cnt = 0u; mine = 0u;
#pragma unroll
        for (unsigned j = 0; j < 16; ++j) { const unsigned c = xb_ld(&bar[XB_XCNT(j)]); sum += c; cnt += (c > 0u) ? 1u : 0u; mine = (j == x) ? c : mine; }
        if (sum == G) break;
        __builtin_amdgcn_s_sleep(1);
        if ((++sp & 255u) == 0u) { if (xb_ld(&bar[XB_TMO])) break; if (sp > XB_SPIN_CAP) { atomicAdd(&bar[XB_TMO], 1u); break; } }
    }
    nloc = mine > 0u ? mine : 1u; nx = cnt > 0u ? cnt : 1u;
}
__device__ __forceinline__ void xcd_barrier(const XcdBarrier& b) {
    asm volatile("s_waitcnt vmcnt(0)" ::: "memory");
    __syncthreads();
    if (threadIdx.x == 0) {
        unsigned* bar = b.bar;
        __builtin_amdgcn_s_waitcnt(0);
        unsigned nloc = b.st[0], nx = b.st[1];
        if (nloc == 0u) { xcd_barrier_complete(bar, b.x, nloc, nx); b.st[0] = nloc; b.st[1] = nx; }
        const unsigned old = xb_add(&bar[XB_XSUB(b.x)], 1u);
        const unsigned gen = old / nloc;
        if (old + 1u == (gen + 1u) * nloc) {
            __builtin_amdgcn_fence(__ATOMIC_RELEASE, "agent");
            asm volatile("s_waitcnt vmcnt(0)" ::: "memory");
            const unsigned og = xb_add(&bar[XB_TOP], 1u);
            const unsigned tg = og / nx;
            if (og + 1u == (tg + 1u) * nx) xb_add(&bar[XB_TOPGEN], 1u);
            else XB_SPIN(xb_ld(&bar[XB_TOPGEN]) == tg, bar);
            __builtin_amdgcn_fence(__ATOMIC_ACQUIRE, "agent");
            xb_add(&bar[XB_XGEN(b.x)], 1u);
            asm volatile("s_waitcnt vmcnt(0)" ::: "memory");
        } else {
            XB_SPIN(xb_ld(&bar[XB_XGEN(b.x)]) == gen, bar);
            __builtin_amdgcn_fence(__ATOMIC_ACQUIRE, "agent");
            asm volatile("s_waitcnt vmcnt(0)" ::: "memory");
        }
    }
    __syncthreads();
}
constexpr int RING_BYTES = 131072, LDSCTL_OFF = RING_BYTES, MISC_OFF = LDSCTL_OFF + 320;
constexpr int LDS_BYTES = 147456;
constexpr int CW_BAR = 4096;

constexpr int N_PHASES = 14;
__device__ __forceinline__ GemmDesc gemm_desc(const Frame& F, int ph) {
    GemmDesc g; float* ST = F.ST; const size_t S1 = (size_t)M * 16;
    g.A = F.XN; g.Bt = F.W_IN; g.N = DM; g.K = DM; g.kind = G_RESID; g.rmode = 0; g.stat = ST; g.nslots = 16; g.inv_dim = 1.0f / DM;
    g.base = nullptr; g.xout = nullptr; g.xn = F.XN; g.stat_out = ST; g.hout = F.H;
    if (ph == 1) { g.Bt = F.W_IN; g.N = N0; g.kind = G_ROWSCALE; g.rmode = R_QKV0; }
    else if (ph == 3) { g.A = F.AO; g.Bt = F.W_OUT; g.base = F.x; g.stat_out = ST + S1; }
    else if (ph == 4) { g.Bt = F.W_GU0; g.N = NGU; g.kind = G_SWIGLU; g.stat = ST + S1; }
    else if (ph == 5) { g.A = F.H; g.Bt = F.W_DN0; g.K = FFH; g.stat_out = ST + 2 * S1; }
    else if (ph == 6) { g.Bt = F.W_MD; g.N = NMD; g.kind = G_ROWSCALE; g.rmode = R_MD; g.stat = ST + 2 * S1; }
    else if (ph == 7) { g.A = F.CQ; g.Bt = F.W_UQ; g.N = NUQ; g.K = QRANK; g.kind = G_ROWSCALE; g.rmode = R_UQ; g.stat = F.SQ; g.nslots = 12; g.inv_dim = 1.0f / QRANK; }
    else if (ph == 8) { g.A = F.CKV; g.Bt = F.W_UKV; g.N = NUKV; g.K = KVRANK; g.kind = G_ROWSCALE; g.rmode = R_UKV; g.stat = F.SKV; g.nslots = 8; g.inv_dim = 1.0f / KVRANK; }
    else if (ph == 10) { g.A = F.AO; g.Bt = F.W_O; g.stat_out = ST + 3 * S1; }
    else if (ph == 11) { g.Bt = F.W_GU1; g.N = NGU; g.kind = G_SWIGLU; g.stat = ST + 3 * S1; }
    else { g.A = F.H; g.Bt = F.W_DN1; g.K = FFH; g.xn = nullptr; g.xout = F.out; g.stat_out = ST + 4 * S1; }
    return g;
}

struct Args { const void* in[18]; float* out; unsigned char* ws; int ph_lo, ph_hi; };
__global__ void __launch_bounds__(NTHR, 2) mk_fwd(Args a) {
    extern __shared__ __attribute__((aligned(16))) unsigned char lds_raw[];
    LAS unsigned char* lds = (LAS unsigned char*)lds_raw;
    Frame F;
    F.tid = threadIdx.x; F.lane = F.tid & 63; F.wave = __builtin_amdgcn_readfirstlane(F.tid >> 6); F.G = gridDim.x; F.bid = blockIdx.x;
    F.x = (const float*)a.in[0]; F.pos = (const int*)a.in[1]; F.attn_norm = (const float*)a.in[2]; F.ffn_norm = (const float*)a.in[3]; F.w_in = (const float*)a.in[4]; F.sinks = (const float*)a.in[5];
    F.w_out = (const float*)a.in[6]; F.relb = (const float*)a.in[7]; F.w_md = (const float*)a.in[8]; F.q_norm = (const float*)a.in[9]; F.w_uq = (const float*)a.in[10]; F.kv_norm = (const float*)a.in[11];
    F.w_ukv = (const float*)a.in[12]; F.w_o = (const float*)a.in[13]; F.w_gate = (const float*)a.in[14]; F.w_up = (const float*)a.in[15]; F.w_down = (const float*)a.in[16]; F.final_norm = (const float*)a.in[17];
    F.out = a.out; F.ws = a.ws; unsigned char* ws = a.ws;
    F.W_IN = (bf16*)(ws + WS_W_IN); F.W_OUT = (bf16*)(ws + WS_W_OUT); F.W_GU0 = (bf16*)(ws + WS_W_GU0); F.W_DN0 = (bf16*)(ws + WS_W_DN0); F.W_MD = (bf16*)(ws + WS_W_MD);
    F.W_UQ = (bf16*)(ws + WS_W_UQ); F.W_UKV = (bf16*)(ws + WS_W_UKV); F.W_O = (bf16*)(ws + WS_W_O); F.W_GU1 = (bf16*)(ws + WS_W_GU1); F.W_DN1 = (bf16*)(ws + WS_W_DN1);
    F.ST = (float*)(ws + WS_ST); F.SQ = (float*)(ws + WS_SQ); F.SKV = (float*)(ws + WS_SKV); F.CS = (f32x2*)(ws + WS_CS);
    F.XN = (bf16*)(ws + WS_XN); F.AO = (bf16*)(ws + WS_AO); F.QKV0 = (bf16*)(ws + WS_QKV0); F.H = (bf16*)(ws + WS_H); F.CQ = (bf16*)(ws + WS_CQ); F.CKV = (bf16*)(ws + WS_CKV);
    F.KR = (bf16*)(ws + WS_KR); F.QN = (bf16*)(ws + WS_QN); F.QR = (bf16*)(ws + WS_QR); F.KN = (bf16*)(ws + WS_KN); F.VV = (bf16*)(ws + WS_VV);

    for (int u = F.tid; u < (LDS_BYTES - LDSCTL_OFF) / 4; u += NTHR) ((LAS unsigned*)(lds + LDSCTL_OFF))[u] = 0u;
    __syncthreads();
    XcdBarrier bar; bar.bar = (unsigned*)(ws + WS_CTL) + CW_BAR; bar.x = 0; bar.st = nullptr;
    if (a.ph_hi - a.ph_lo > 1) bar = xcd_barrier_post((unsigned*)(ws + WS_CTL) + CW_BAR, (volatile LAS unsigned*)(lds + MISC_OFF) + 8);
    for (int ph = a.ph_lo; ph < a.ph_hi; ++ph) {
#if PROBE_MASK
      for (int rep = 0; rep <= ((PROBE_MASK >> ph) & 1); ++rep) {
        if (rep) xcd_barrier(bar);
#endif
        { int t_; asm volatile("v_mov_b32 %0, %1" : "=v"(t_) : "v"(threadIdx.x)); F.tid = t_; F.lane = t_ & 63; }
        if (ph == 0) p0_prologue(F, lds);
        else if (ph == 2) {
#if !USE_FAST_SB
            naive_sb(F);
#endif
#if !USE_FAST_SWA
            naive_swa(F);
#endif
#if USE_FAST_SB || USE_FAST_SWA
            att::attn0_phase(F, lds);
#endif
        }
        else if (ph == 9) {
#if USE_FAST_MLA
            att::attn1_phase(F, lds);
#else
            naive_mla(F);
#endif
        }
        else if (ph == 13) final_norm_phase(F);
        else {
            const GemmDesc g = gemm_desc(F, ph);
#if USE_FAST_GEMM
            const pg8::Gemm pg{g.A, g.Bt, M, g.N, g.K}; pg8::StaticOrder S; S.init(M, g.N, F.G, F.bid);
            if (g.kind == G_ROWSCALE) { const pg8::EpiRowScale E{&F, g.rmode, g.stat, g.nslots, g.inv_dim}; pg8::gemm_phase<pg8::EpiRowScale, pg8::StaticOrder, true, true>(lds, pg, S, E); }
            else if (g.kind == G_SWIGLU) { const pg8::EpiSwiGLU E{g.hout, g.stat, g.nslots, g.inv_dim}; pg8::gemm_phase<pg8::EpiSwiGLU, pg8::StaticOrder, true, true>(lds, pg, S, E); }
            else { const pg8::EpiResid E{g.base, g.xout, g.xn, F.XN, g.stat_out}; pg8::gemm_phase<pg8::EpiResid, pg8::StaticOrder, true, true>(lds, pg, S, E); }
#else
            naive_gemm_phase(F, g);
#endif
        }
#if PROBE_MASK
      }
#endif
        if (ph + 1 < a.ph_hi && ph != 7) xcd_barrier(bar);
    }
}

extern "C" void kernel_launch(void* const* d_in, const int* in_sizes, int n_in, void* d_out, int out_size, void* d_ws, size_t ws_size, hipStream_t stream) {
    static int grid = 0;
    if (grid == 0) {
        if (n_in != 18 || in_sizes[0] != M * DM || out_size != M * DM || ws_size < WS_END) { fprintf(stderr, "kernel_launch: unexpected problem shape / workspace (n_in %d, ws %zu)\n", n_in, ws_size); grid = -1; return; }
        int dev = 0, cus = 0;
        if (hipGetDevice(&dev) != hipSuccess || hipDeviceGetAttribute(&cus, hipDeviceAttributeMultiprocessorCount, dev) != hipSuccess) { grid = -1; return; }
        if (hipFuncSetAttribute((const void*)mk_fwd, hipFuncAttributeMaxDynamicSharedMemorySize, LDS_BYTES) != hipSuccess) { fprintf(stderr, "kernel_launch: hipFuncSetAttribute failed\n"); grid = -1; return; }
        grid = cus;
    }
    if (grid < 0) return;
    Args a{};
    for (int i = 0; i < 18; ++i) a.in[i] = d_in[i];
    a.out = (float*)d_out; a.ws = (unsigned char*)d_ws;
#if MK_ONE_LAUNCH
    if (hipMemsetAsync((char*)d_ws + WS_CTL, 0, 65536, stream) != hipSuccess) { fprintf(stderr, "kernel_launch: memset failed\n"); return; }
    a.ph_lo = 0; a.ph_hi = N_PHASES;
    void* kargs[] = {&a};
    const hipError_t e = hipLaunchCooperativeKernel((const void*)mk_fwd, dim3(grid), dim3(NTHR), kargs, LDS_BYTES, stream);
    if (e != hipSuccess) fprintf(stderr, "kernel_launch: cooperative launch failed: %s (grid %d)\n", hipGetErrorString(e), grid);
#else
    for (int ph = 0; ph < N_PHASES; ++ph) {
        a.ph_lo = ph; a.ph_hi = ph + 1;
        hipLaunchKernelGGL(mk_fwd, dim3(grid), dim3(NTHR), LDS_BYTES, stream, a);
    }
#endif
}
```

```cpp
#include <hip/hip_runtime.h>
#include <cstdio>
#include <cstdint>

#ifndef MK_ONE_LAUNCH
#define MK_ONE_LAUNCH 1
#endif
#ifndef PROBE_MASK
#define PROBE_MASK 0
#endif
#ifndef USE_FAST_GEMM
#define USE_FAST_GEMM 1
#endif
#ifndef USE_FAST_SB
#define USE_FAST_SB 1
#endif
#ifndef USE_FAST_SWA
#define USE_FAST_SWA 1
#endif
#ifndef USE_FAST_MLA
#define USE_FAST_MLA 1
#endif

#define GAS __attribute__((address_space(1)))
#define LAS __attribute__((address_space(3)))
typedef unsigned short bf16;
typedef short bf16x8 __attribute__((ext_vector_type(8)));
typedef float f32x4 __attribute__((ext_vector_type(4)));
typedef float f32x2 __attribute__((ext_vector_type(2)));
typedef unsigned u32x4 __attribute__((ext_vector_type(4)));
typedef unsigned u32x2 __attribute__((ext_vector_type(2)));

constexpr int BATCH = 4, SEQ = 4096, DM = 1024, M = BATCH * SEQ;
constexpr int N0 = 2304, FFH = 2816, NGU = 2 * FFH, NMD = 768, QRANK = 384, KVRANK = 256, NUQ = 1536, NUKV = 2048;
constexpr float EPS = 1e-6f;
constexpr float LOG2E = 1.4426950408889634f;
constexpr int NWAVES = 8, NTHR = 512;

constexpr size_t MiB = 1u << 20;
constexpr size_t WS_CTL = 0, CTL_ZERO_BYTES = 1 * MiB;
constexpr size_t WS_W_IN = 1 * MiB;
constexpr size_t WS_W_OUT = WS_W_IN + (size_t)N0 * DM * 2;
constexpr size_t WS_W_GU0 = WS_W_OUT + (size_t)DM * DM * 2;
constexpr size_t WS_W_DN0 = WS_W_GU0 + (size_t)NGU * DM * 2;
constexpr size_t WS_W_MD = WS_W_DN0 + (size_t)DM * FFH * 2;
constexpr size_t WS_W_UQ = WS_W_MD + (size_t)NMD * DM * 2;
constexpr size_t WS_W_UKV = WS_W_UQ + (size_t)NUQ * QRANK * 2;
constexpr size_t WS_W_O = WS_W_UKV + (size_t)NUKV * KVRANK * 2;
constexpr size_t WS_W_GU1 = WS_W_O + (size_t)DM * DM * 2;
constexpr size_t WS_W_DN1 = WS_W_GU1 + (size_t)NGU * DM * 2;
constexpr size_t WS_W_END = WS_W_DN1 + (size_t)DM * FFH * 2;
static_assert(WS_W_END <= 47 * MiB, "weights");
constexpr size_t WS_ST = 47 * MiB;
constexpr size_t WS_SQ = 52 * MiB, WS_SKV = 53 * MiB;
constexpr size_t WS_CS = 54 * MiB;
constexpr size_t WS_XN = 56 * MiB;
constexpr size_t WS_AO = 88 * MiB;
constexpr size_t WS_BIG = 120 * MiB;
constexpr size_t WS_QKV0 = WS_BIG;
constexpr size_t WS_H = WS_BIG;
constexpr size_t WS_CQ = WS_BIG;
constexpr size_t WS_CKV = WS_BIG + 12 * MiB;
constexpr size_t WS_KR = WS_BIG + 20 * MiB;
constexpr size_t WS_QN = WS_BIG + 21 * MiB;
constexpr size_t WS_QR = WS_BIG + 53 * MiB;
constexpr size_t WS_KN = WS_BIG + 69 * MiB;
constexpr size_t WS_VV = WS_BIG + 101 * MiB;
constexpr size_t WS_END = WS_BIG + 133 * MiB;
static_assert(WS_END <= 256 * MiB, "d_ws map");

__device__ __forceinline__ unsigned f2bf(float f) { unsigned u = __builtin_bit_cast(unsigned, f); return (u + 0x7fffu + ((u >> 16) & 1u)) >> 16; }
__device__ __forceinline__ unsigned pk2(float lo, float hi) { return f2bf(lo) | (f2bf(hi) << 16); }
typedef __bf16 bf16x2_g __attribute__((ext_vector_type(2)));
__device__ __forceinline__ unsigned cvtpk_g(float lo, float hi) { f32x2 v = {lo, hi}; bf16x2_g b = __builtin_convertvector(v, bf16x2_g); return __builtin_bit_cast(unsigned, b); }
__device__ __forceinline__ float bf2f(unsigned short b) { return __builtin_bit_cast(float, (unsigned)b << 16); }
__device__ __forceinline__ float wave_sum(float v) {
#pragma unroll
    for (int o = 1; o < 64; o <<= 1) v += __shfl_xor(v, o);
    return v;
}

struct Frame {
    int tid, lane, wave, G, bid;
    const float* x; const int* pos; const float* attn_norm; const float* ffn_norm; const float* w_in; const float* sinks; const float* w_out; const float* relb;
    const float* w_md; const float* q_norm; const float* w_uq; const float* kv_norm; const float* w_ukv; const float* w_o; const float* w_gate; const float* w_up; const float* w_down; const float* final_norm;
    float* out; unsigned char* ws;
    bf16 *W_IN, *W_OUT, *W_GU0, *W_DN0, *W_MD, *W_UQ, *W_UKV, *W_O, *W_GU1, *W_DN1;
    float *ST, *SQ, *SKV; f32x2* CS;
    bf16 *XN, *AO, *QKV0, *H, *CQ, *CKV, *KR, *QN, *QR, *KN, *VV;
};

__device__ __forceinline__ float row_rstd(const float* st, int row, int nslots, float inv_dim) {
    const f32x4* p = (const f32x4*)(st + (size_t)row * 16); float s = 0.f;
#pragma unroll
    for (int i = 0; i < 4; ++i) if (4 * i < nslots) { const f32x4 v = p[i]; s += (v.x + v.y) + (v.z + v.w); }
    return 1.0f / sqrtf(s * inv_dim + EPS);
}

enum { R_QKV0 = 0, R_MD = 1, R_UQ = 2, R_UKV = 3 };
struct Route { bf16* dst; int pitch; int col; int rope; int wc0only; float* stat; int slot; };
__device__ __forceinline__ Route route(const Frame& F, int mode, int hh) {
    Route r; r.rope = 0; r.wc0only = 0; r.slot = 0; size_t off, soff = 0; int st = 0;
    if (mode == R_QKV0) { off = WS_QKV0; r.pitch = N0; r.col = hh * 128; }
    else if (mode == R_MD) {
        if (hh < 3) { off = WS_CQ; r.pitch = QRANK; r.col = hh * 128; st = 1; soff = WS_SQ; r.slot = hh * 4; }
        else if (hh == 3) { off = WS_KR; r.pitch = 32; r.col = 0; r.rope = 1; r.wc0only = 1; }
        else { off = WS_CKV; r.pitch = KVRANK; r.col = (hh - 4) * 128; st = 1; soff = WS_SKV; r.slot = (hh - 4) * 4; }
    } else if (mode == R_UQ) {
        if (hh < 8) { off = WS_QN; r.pitch = 1024; r.col = hh * 128; }
        else { off = WS_QR; r.pitch = 512; r.col = (hh - 8) * 128; r.rope = 1; }
    } else {
        if (hh < 8) { off = WS_KN; r.pitch = 1024; r.col = hh * 128; }
        else { off = WS_VV; r.pitch = 1024; r.col = (hh - 8) * 128; }
    }
    r.dst = (bf16*)(F.ws + off); r.stat = st ? (float*)(F.ws + soff) : nullptr;
    return r;
}

namespace pg8 {
#define PG8_LAS __attribute__((address_space(3)))
typedef unsigned short bf16_t;
typedef short bf16x8 __attribute__((ext_vector_type(8)));
typedef float f32x4 __attribute__((ext_vector_type(4)));
typedef unsigned u32x4 __attribute__((ext_vector_type(4)));
constexpr int BM = 256, BK = 64, HALF = 128, HTB = HALF * BK * 2  , STAGE_BYTES = 8 * HTB, NXCD = 8, WGM = 8;

__host__ __device__ __forceinline__ int lds_byte(int r, int c) { const int st = (r >> 4) * 2 + (c >> 5), rr = r & 15, cc = c & 31, ob = rr * 64 + cc * 2; return st * 1024 + (ob ^ (((ob >> 9) & 1) << 5)); }
__host__ __device__ __forceinline__ void stage_rc(int b, int& R, int& C) { const int st = b / 1024, sb = b % 1024, swz = sb ^ (((sb >> 9) & 1) << 5); R = (st >> 1) * 16 + swz / 64; C = (st & 1) * 32 + (swz % 64) / 2; }
__host__ __device__ __forceinline__ int perm32(int rho) { const int n = rho >> 4, i = rho & 15; return 8 * (i >> 2) + 4 * n + (i & 3); }

struct Unit { int pm, pn; };
struct Gemm { const bf16_t* A; const bf16_t* Bt; int M, N, K; };

struct StaticOrder {
    int nM, nN, nwg, G, c;
    __host__ __device__ void init(int M, int N, int G_, int c_) { nM = M / BM; nN = N / BM; nwg = nM * nN; G = G_; c = c_; }
    __host__ __device__ bool next(int i, Unit& u) const {
        const long L = (long)i * G + c; if (L >= nwg) return false;
        int wgid = (int)L; { const int q = nwg / NXCD, r = nwg % NXCD, xcd = wgid % NXCD, off = wgid / NXCD; wgid = (xcd < r ? xcd * (q + 1) : r * (q + 1) + (xcd - r) * q) + off; }
        const int nig = WGM * nN, gid = wgid / nig, fm = gid * WGM, gsz = (nM - fm) < WGM ? (nM - fm) : WGM;
        u.pm = fm + ((wgid % nig) % gsz); u.pn = (wgid % nig) / gsz; return true;
    }
    __device__ __forceinline__ void a_ready(const Unit&) const {}
    __device__ __forceinline__ void done(const Unit&) const {}
};

typedef __bf16 bf16x2_t __attribute__((ext_vector_type(2)));
typedef float f32x2v __attribute__((ext_vector_type(2)));
__device__ __forceinline__ unsigned cvtpk(float lo, float hi) { f32x2v v = {lo, hi}; bf16x2_t b = __builtin_convertvector(v, bf16x2_t); return __builtin_bit_cast(unsigned, b); }

struct EpiRowScale {
    static constexpr bool PERM = true, AFTER_DRAIN = false;
    const ::Frame* F; int rmode; const float* stat; int nslots; float inv_dim;
    __device__ __forceinline__ void operator()(const f32x4 (&acc)[2][2][4][2], const Unit& u, int wr, int wc, int fr, int fq) const {
        const int row0 = u.pm * BM + wr * 64 + fr;
        float rs[2][4];
#pragma unroll
        for (int ai = 0; ai < 2; ++ai)
#pragma unroll
            for (int m = 0; m < 4; ++m) rs[ai][m] = ::row_rstd(stat, row0 + ai * HALF + m * 16, nslots, inv_dim);
#pragma unroll
        for (int bj = 0; bj < 2; ++bj) {
            const ::Route rt = ::route(*F, rmode, u.pn * 2 + bj);
            if (rt.wc0only && wc != 0) continue;
#pragma unroll
            for (int ai = 0; ai < 2; ++ai)
#pragma unroll
                for (int m = 0; m < 4; ++m) {
                    const int row = row0 + ai * HALF + m * 16;
                    f32x4 v0 = acc[ai][bj][m][0] * rs[ai][m], v1 = acc[ai][bj][m][1] * rs[ai][m];
                    if (rt.stat) {
                        float ss = (v0[0] * v0[0] + v0[1] * v0[1]) + (v0[2] * v0[2] + v0[3] * v0[3]) + (v1[0] * v1[0] + v1[1] * v1[1]) + (v1[2] * v1[2] + v1[3] * v1[3]);
                        ss += __shfl_xor(ss, 16); ss += __shfl_xor(ss, 32);
                        if (fq == 0) rt.stat[(size_t)row * 16 + rt.slot + wc] = ss;
                    }
                    if (rt.rope) {
                        const f32x4* csp = (const f32x4*)(F->CS + (size_t)row * 16 + 8 * (fq & 1));
                        const f32x4 c0 = csp[0], c1 = csp[1], c2 = csp[2], c3 = csp[3];
                        f32x4 p0, p1;
#pragma unroll
                        for (int j = 0; j < 4; ++j) { p0[j] = __shfl_xor(v0[j], 32); p1[j] = __shfl_xor(v1[j], 32); }
                        const float sg = fq < 2 ? -1.0f : 1.0f;
                        v0[0] = v0[0] * c0[0] + sg * p0[0] * c0[1]; v0[1] = v0[1] * c0[2] + sg * p0[1] * c0[3]; v0[2] = v0[2] * c1[0] + sg * p0[2] * c1[1]; v0[3] = v0[3] * c1[2] + sg * p0[3] * c1[3];
                        v1[0] = v1[0] * c2[0] + sg * p1[0] * c2[1]; v1[1] = v1[1] * c2[2] + sg * p1[1] * c2[3]; v1[2] = v1[2] * c3[0] + sg * p1[2] * c3[1]; v1[3] = v1[3] * c3[2] + sg * p1[3] * c3[3];
                    }
                    u32x4 w; w.x = cvtpk(v0[0], v0[1]); w.y = cvtpk(v0[2], v0[3]); w.z = cvtpk(v1[0], v1[1]); w.w = cvtpk(v1[2], v1[3]);
                    *(u32x4*)(rt.dst + (size_t)row * rt.pitch + rt.col + wc * 32 + 8 * fq) = w;
                }
        }
    }
};
struct EpiSwiGLU {
    static constexpr bool PERM = true, AFTER_DRAIN = false;
    bf16_t* H; const float* stat; int nslots; float inv_dim;
    __device__ __forceinline__ void operator()(const f32x4 (&acc)[2][2][4][2], const Unit& u, int wr, int wc, int fr, int fq) const {
        const int row0 = u.pm * BM + wr * 64 + fr, col0 = u.pn * 128 + wc * 32 + 8 * fq;
#pragma unroll
        for (int ai = 0; ai < 2; ++ai)
#pragma unroll
            for (int m = 0; m < 4; ++m) {
                const int row = row0 + ai * HALF + m * 16; const float rs = ::row_rstd(stat, row, nslots, inv_dim);
                float hv[8];
#pragma unroll
                for (int n = 0; n < 2; ++n)
#pragma unroll
                    for (int j = 0; j < 4; ++j) { const float g = acc[ai][0][m][n][j] * rs, up = acc[ai][1][m][n][j] * rs;
                        hv[4 * n + j] = g * up * __builtin_amdgcn_rcpf(1.0f + __builtin_amdgcn_exp2f(-g * ::LOG2E)); }
                u32x4 w; w.x = cvtpk(hv[0], hv[1]); w.y = cvtpk(hv[2], hv[3]); w.z = cvtpk(hv[4], hv[5]); w.w = cvtpk(hv[6], hv[7]);
                *(u32x4*)(H + (size_t)row * ::FFH + col0) = w;
            }
    }
};
struct EpiResid {
    static constexpr bool PERM = false, AFTER_DRAIN = false;
    const float* base; float* xout; bf16_t* xn; const bf16_t* xb; float* stat_out;
    __device__ __forceinline__ void operator()(const f32x4 (&acc)[2][2][4][2], const Unit& u, int wr, int wc, int fr, int fq) const {
        typedef unsigned u32x2v __attribute__((ext_vector_type(2)));
        const int row0 = u.pm * BM + wr * 64 + fr, col0 = u.pn * BM + wc * 32 + 4 * fq;
#pragma unroll
        for (int ai = 0; ai < 2; ++ai)
#pragma unroll
            for (int m = 0; m < 4; ++m) {
                const int row = row0 + ai * HALF + m * 16; const size_t ro = (size_t)row * ::DM + col0; float ss = 0.f;
#pragma unroll
                for (int bj = 0; bj < 2; ++bj)
#pragma unroll
                    for (int n = 0; n < 2; ++n) { const size_t o = ro + bj * HALF + n * 16; f32x4 v;
                        if (base) v = *(const f32x4*)(base + o);
                        else { const u32x2v w = *(const u32x2v*)(xb + o); v = (f32x4){__builtin_bit_cast(float, w.x << 16), __builtin_bit_cast(float, w.x & 0xffff0000u), __builtin_bit_cast(float, w.y << 16), __builtin_bit_cast(float, w.y & 0xffff0000u)}; }
                        v = v + acc[ai][bj][m][n];
                        if (xout) *(f32x4*)(xout + o) = v;
                        ss += (v[0] * v[0] + v[1] * v[1]) + (v[2] * v[2] + v[3] * v[3]);
                        if (xn) *(u32x2v*)(xn + o) = (u32x2v){cvtpk(v[0], v[1]), cvtpk(v[2], v[3])}; }
                ss += __shfl_xor(ss, 16); ss += __shfl_xor(ss, 32);
                if (fq == 0) stat_out[(size_t)row * 16 + u.pn * 4 + wc] = ss;
            }
    }
};

template <class Epi, class Sched, bool ALIGN_EPI = false, bool SP2 = false>
__device__ __forceinline__ void gemm_phase(PG8_LAS unsigned char* lds, const Gemm g, const Sched& S, const Epi& E) {
    int tid; asm volatile("v_mov_b32 %0, %1" : "=v"(tid) : "v"(threadIdx.x));
    const int wid = __builtin_amdgcn_readfirstlane(tid >> 6), lane = tid & 63, wr = wid >> 2, wc = wid & 3, fr = lane & 15, fq = lane >> 4;
    const int K = g.K, nt = K / BK;
    unsigned voffA[2], voffB[2];
#pragma unroll
    for (int i = 0; i < 2; ++i) { int R, C; stage_rc(tid * 16 + i * 8192, R, C); const int Rb = Epi::PERM ? ((R & ~31) + perm32(R & 31)) : R;
        voffA[i] = (unsigned)(R * K + C) * 2u; voffB[i] = (unsigned)(Rb * K + C) * 2u; }
    const size_t kstep = (size_t)(BK * 2);
    const size_t hstep = (size_t)HALF * K * 2;
    const size_t tstep = 2 * hstep;
    const unsigned ldsw = (unsigned)wid * 1024u;
    const int aoff = lds_byte(wr * 64 + fr, fq * 8), boff = lds_byte(wc * 32 + fr, fq * 8);
#define PG8_SA(b, h) (((b) * 2 + (h)) * HTB)
#define PG8_SB(b, h) ((4 + (b) * 2 + (h)) * HTB)
#define PG8_STAGE(bufoff, gbase, voff) do { _Pragma("unroll") for (int _i = 0; _i < 2; ++_i) \
        __builtin_amdgcn_global_load_lds((const unsigned*)((const char*)(gbase) + (voff)[_i]), (PG8_LAS unsigned*)(lds + (bufoff) + ldsw + _i * 8192), 16, 0, 0); } while (0)
#define PG8_LDA(dst, b, h) do { _Pragma("unroll") for (int m = 0; m < 4; ++m) _Pragma("unroll") for (int k = 0; k < 2; ++k) dst[m][k] = *(const PG8_LAS bf16x8*)(lds + PG8_SA(b, h) + aoff + m * 2048 + k * 1024); } while (0)
#define PG8_LDB(dst, b, h) do { _Pragma("unroll") for (int n = 0; n < 2; ++n) _Pragma("unroll") for (int k = 0; k < 2; ++k) dst[n][k] = *(const PG8_LAS bf16x8*)(lds + PG8_SB(b, h) + boff + n * 2048 + k * 1024); } while (0)
#define PG8_MMA(ai, bj, At, Bt) do { __builtin_amdgcn_s_setprio(1); _Pragma("unroll") for (int m = 0; m < 4; ++m) _Pragma("unroll") for (int n = 0; n < 2; ++n) _Pragma("unroll") for (int k = 0; k < 2; ++k) \
        acc[ai][bj][m][n] = __builtin_amdgcn_mfma_f32_16x16x32_bf16(Bt[n][k], At[m][k], acc[ai][bj][m][n], 0, 0, 0); __builtin_amdgcn_s_setprio(0); } while (0)
#define PG8_WAIT_V(n) asm volatile("s_waitcnt vmcnt(" #n ")" ::: "memory")
#define PG8_WAIT_L(n) asm volatile("s_waitcnt lgkmcnt(" #n ")" ::: "memory")
#define PG8_BAR __builtin_amdgcn_s_barrier()
#define PG8_SCHED __builtin_amdgcn_sched_barrier(0)
    Unit cur, nxt; int ui = 0;
    if (!S.next(0, cur)) return;
    f32x4 acc[2][2][4][2];
#pragma unroll
    for (int a = 0; a < 2; ++a)
#pragma unroll
        for (int b = 0; b < 2; ++b)
#pragma unroll
            for (int m = 0; m < 4; ++m)
#pragma unroll
                for (int n = 0; n < 2; ++n) acc[a][b][m][n] = (f32x4){0.f, 0.f, 0.f, 0.f};
    bf16x8 At[4][2], B0[2][2], B1[2][2];
    const char* cA = (const char*)g.A + (size_t)cur.pm * tstep; const char* cB = (const char*)g.Bt + (size_t)cur.pn * tstep;
    S.a_ready(cur);
    if constexpr (SP2) {
        PG8_STAGE(PG8_SB(0, 0), cB, voffB); PG8_STAGE(PG8_SB(0, 1), cB + hstep, voffB); PG8_STAGE(PG8_SA(0, 0), cA, voffA); PG8_STAGE(PG8_SA(0, 1), cA + hstep, voffA);
        if (wr == 1) PG8_BAR;
        PG8_WAIT_V(2); PG8_BAR;
        PG8_STAGE(PG8_SB(1, 0), cB + kstep, voffB); PG8_STAGE(PG8_SA(1, 0), cA + kstep, voffA); PG8_STAGE(PG8_SB(1, 1), cB + hstep + kstep, voffB);
        PG8_WAIT_V(6); PG8_BAR;
    } else {
        PG8_STAGE(PG8_SB(0, 0), cB, voffB); PG8_STAGE(PG8_SA(0, 0), cA, voffA); PG8_STAGE(PG8_SB(0, 1), cB + hstep, voffB); PG8_STAGE(PG8_SA(0, 1), cA + hstep, voffA);
        if (wr == 1) PG8_BAR;
        PG8_WAIT_V(4); PG8_BAR;
        PG8_STAGE(PG8_SB(1, 0), cB + kstep, voffB); PG8_STAGE(PG8_SA(1, 0), cA + kstep, voffA); PG8_STAGE(PG8_SB(1, 1), cB + hstep + kstep, voffB);
        PG8_WAIT_V(6); PG8_BAR;
    }
    for (;;) {
        const bool has_next = S.next(ui + 1, nxt);
        const char* nA = has_next ? (const char*)g.A + (size_t)nxt.pm * tstep : cA; const char* nB = has_next ? (const char*)g.Bt + (size_t)nxt.pn * tstep : cB;
        for (int t = 0; t < nt; t += 2) {
            const bool last = (t == nt - 2);
            const char* a1 = cA + (size_t)(t + 1) * kstep;
            const char* a2 = last ? nA : cA + (size_t)(t + 2) * kstep; const char* b2 = last ? nB : cB + (size_t)(t + 2) * kstep;
            const char* a3 = a2 + kstep; const char* b3 = b2 + kstep;
            if (last && has_next) S.a_ready(nxt);
            if constexpr (SP2) {
            PG8_LDB(B0, 0, 0); PG8_LDB(B1, 0, 1); PG8_SCHED; PG8_LDA(At, 0, 0); PG8_STAGE(PG8_SA(1, 1), a1 + hstep, voffA);
            PG8_WAIT_V(8); PG8_WAIT_L(0); PG8_BAR; PG8_MMA(0, 0, At, B0); PG8_MMA(0, 1, At, B1); PG8_BAR; PG8_SCHED;
            PG8_LDA(At, 0, 1); PG8_STAGE(PG8_SB(0, 0), b2, voffB); PG8_STAGE(PG8_SB(0, 1), b2 + hstep, voffB); PG8_STAGE(PG8_SA(0, 0), a2, voffA);
            PG8_WAIT_V(8); PG8_WAIT_L(0); PG8_BAR; PG8_MMA(1, 0, At, B0); PG8_MMA(1, 1, At, B1); PG8_BAR; PG8_SCHED;
            PG8_LDB(B0, 1, 0); PG8_LDB(B1, 1, 1); PG8_SCHED; PG8_LDA(At, 1, 0); PG8_STAGE(PG8_SA(0, 1), a2 + hstep, voffA);
            PG8_WAIT_V(8); PG8_WAIT_L(0); PG8_BAR; PG8_MMA(0, 0, At, B0); PG8_MMA(0, 1, At, B1); PG8_BAR; PG8_SCHED;
            PG8_LDA(At, 1, 1); PG8_STAGE(PG8_SB(1, 0), b3, voffB); PG8_STAGE(PG8_SB(1, 1), b3 + hstep, voffB); PG8_STAGE(PG8_SA(1, 0), a3, voffA);
            PG8_WAIT_V(8); PG8_WAIT_L(0); PG8_BAR; PG8_MMA(1, 0, At, B0); PG8_MMA(1, 1, At, B1); PG8_BAR; PG8_SCHED;
            } else {
            PG8_LDB(B0, 0, 0); PG8_SCHED; PG8_LDA(At, 0, 0); PG8_STAGE(PG8_SA(1, 1), a1 + hstep, voffA);
            PG8_WAIT_L(8); PG8_BAR; PG8_WAIT_L(0); PG8_MMA(0, 0, At, B0); PG8_BAR; PG8_SCHED;
            PG8_LDB(B1, 0, 1); PG8_STAGE(PG8_SB(0, 0), b2, voffB);
            PG8_BAR; PG8_WAIT_L(0); PG8_MMA(0, 1, At, B1); PG8_BAR;
            PG8_LDA(At, 0, 1); PG8_STAGE(PG8_SA(0, 0), a2, voffA);
            PG8_BAR; PG8_WAIT_L(0); PG8_MMA(1, 0, At, B0); PG8_BAR; PG8_SCHED;
            PG8_STAGE(PG8_SB(0, 1), b2 + hstep, voffB);
            PG8_WAIT_V(6); PG8_BAR; PG8_MMA(1, 1, At, B1); PG8_BAR;
            PG8_LDB(B0, 1, 0); PG8_SCHED; PG8_LDA(At, 1, 0); PG8_STAGE(PG8_SA(0, 1), a2 + hstep, voffA);
            PG8_WAIT_L(8); PG8_BAR; PG8_WAIT_L(0); PG8_MMA(0, 0, At, B0); PG8_BAR; PG8_SCHED;
            PG8_LDB(B1, 1, 1); PG8_STAGE(PG8_SB(1, 0), b3, voffB);
            PG8_BAR; PG8_WAIT_L(0); PG8_MMA(0, 1, At, B1); PG8_BAR;
            PG8_LDA(At, 1, 1); PG8_STAGE(PG8_SA(1, 0), a3, voffA);
            PG8_BAR; PG8_WAIT_L(0); PG8_MMA(1, 0, At, B0); PG8_BAR; PG8_SCHED;
            PG8_STAGE(PG8_SB(1, 1), b3 + hstep, voffB);
            PG8_WAIT_V(6); PG8_BAR; PG8_MMA(1, 1, At, B1); PG8_BAR;
            }
        }
        if constexpr (ALIGN_EPI) { if (wr == 0) PG8_BAR; }
        if constexpr (!Epi::AFTER_DRAIN) { E(acc, cur, wr, wc, fr, fq); S.done(cur); }
        if (!has_next) break;
#pragma unroll
        for (int a = 0; a < 2; ++a)
#pragma unroll
            for (int b = 0; b < 2; ++b)
#pragma unroll
                for (int m = 0; m < 4; ++m)
#pragma unroll
                    for (int n = 0; n < 2; ++n) acc[a][b][m][n] = (f32x4){0.f, 0.f, 0.f, 0.f};
        cur = nxt; cA = nA; cB = nB; ++ui;
        if constexpr (ALIGN_EPI) { if (wr == 1) PG8_BAR; }
    }
    PG8_WAIT_V(0);
    if constexpr (!ALIGN_EPI) { if (wr == 0) PG8_BAR; }
    PG8_BAR;
    if constexpr (Epi::AFTER_DRAIN) { E.fused(acc, cur, wr, wc, fr, fq, lds, wid, lane); S.done(cur); }
#undef PG8_SA
#undef PG8_SB
#undef PG8_STAGE
#undef PG8_LDA
#undef PG8_LDB
#undef PG8_MMA
#undef PG8_WAIT_V
#undef PG8_WAIT_L
#undef PG8_BAR
#undef PG8_SCHED
}
}

enum { WM_IN = 0, WM_PLAIN = 1, WM_GATE = 2, WM_UP = 3, WM_MD = 4, WM_UQ = 5, WM_UKV = 6 };
__device__ __forceinline__ int wmap_row(int mode, int n) {
    switch (mode) {
        case WM_GATE: return (n >> 7) * 256 + (n & 127);
        case WM_UP: return (n >> 7) * 256 + 128 + (n & 127);
        case WM_MD: return n < 384 ? n : (n < 640 ? n + 128 : n - 256);
        case WM_UQ: { const int h = n / 96, e = n % 96; return e < 64 ? h * 64 + e : 1024 + h * 32 + (e - 64); }
        case WM_UKV: { const int h = n >> 7, e = n & 127; return e < 64 ? h * 64 + e : 1024 + h * 64 + (e - 64); }
        default: return n;
    }
}
__device__ __forceinline__ float wmap_scale(int mode, int n) {
    if (mode == WM_IN) return (n < 512 || (n >= 1536 && n < 2048)) ? 0.125f * LOG2E : 1.0f;
    if (mode == WM_UQ) return 0.10206207261596577f * LOG2E;
    return 1.0f;
}
struct WJob { const float* W; const float* gain; int K, N; bf16* WT; int mode; };
__device__ __forceinline__ void p0_convert_item(const WJob& w, int item, int lane) {
    const int nblk = (w.N + 63) >> 6, kb = item / nblk, nb = item - kb * nblk, k0 = 64 * kb, n = nb * 64 + lane;
    const bool ok = n < w.N;
    const float* src = w.W + (size_t)k0 * w.N + (ok ? n : 0);
    float v[64];
#pragma unroll
    for (int t = 0; t < 64; ++t) v[t] = src[(size_t)t * w.N];
    if (w.gain) {
#pragma unroll
        for (int t = 0; t < 64; ++t) v[t] *= w.gain[k0 + t];
    }
    const float sc = wmap_scale(w.mode, n);
    if (ok) { bf16* dst = w.WT + (size_t)wmap_row(w.mode, n) * w.K + k0;
#pragma unroll
        for (int c = 0; c < 8; ++c) *(u32x4*)(dst + 8 * c) = (u32x4){cvtpk_g(v[8 * c] * sc, v[8 * c + 1] * sc), cvtpk_g(v[8 * c + 2] * sc, v[8 * c + 3] * sc), cvtpk_g(v[8 * c + 4] * sc, v[8 * c + 5] * sc), cvtpk_g(v[8 * c + 6] * sc, v[8 * c + 7] * sc)}; }
}
__device__ __forceinline__ WJob wjob(const Frame& F, int j) {
    switch (j) {
        case 0: return WJob{F.w_in, F.attn_norm, DM, N0, F.W_IN, WM_IN};
        case 1: return WJob{F.w_out, nullptr, DM, DM, F.W_OUT, WM_PLAIN};
        case 2: return WJob{F.w_gate, F.ffn_norm, DM, FFH, F.W_GU0, WM_GATE};
        case 3: return WJob{F.w_up, F.ffn_norm, DM, FFH, F.W_GU0, WM_UP};
        case 4: return WJob{F.w_down, nullptr, FFH, DM, F.W_DN0, WM_PLAIN};
        case 5: return WJob{F.w_md, F.attn_norm + DM, DM, 672, F.W_MD, WM_MD};
        case 6: return WJob{F.w_uq, F.q_norm, QRANK, NUQ, F.W_UQ, WM_UQ};
        case 7: return WJob{F.w_ukv, F.kv_norm, KVRANK, NUKV, F.W_UKV, WM_UKV};
        case 8: return WJob{F.w_o, nullptr, DM, DM, F.W_O, WM_PLAIN};
        case 9: return WJob{F.w_gate + (size_t)DM * FFH, F.ffn_norm + DM, DM, FFH, F.W_GU1, WM_GATE};
        case 10: return WJob{F.w_up + (size_t)DM * FFH, F.ffn_norm + DM, DM, FFH, F.W_GU1, WM_UP};
        default: return WJob{F.w_down + (size_t)FFH * DM, nullptr, FFH, DM, F.W_DN1, WM_PLAIN};
    }
}
__device__ __forceinline__ void p0_prologue(const Frame& F, LAS unsigned char* lds) {
    const int gw = F.bid * NWAVES + F.wave, NGW = F.G * NWAVES;
    { int it = gw, base = 0;
#pragma unroll
      for (int j = 0; j < 12; ++j) { const WJob w = wjob(F, j); const int end = base + (w.K / 64) * ((w.N + 63) / 64);
          for (; it < end; it += NGW) p0_convert_item(w, it - base, F.lane);
          base = end; } }
    for (int i = gw * 64 + F.lane; i < 96 * DM / 8; i += NGW * 64) *(u32x4*)(F.W_MD + (size_t)416 * DM + (size_t)i * 8) = (u32x4){0u, 0u, 0u, 0u};
    for (int m = gw; m < M; m += NGW) {
        const f32x4* xr = (const f32x4*)(F.x + (size_t)m * DM) + F.lane; f32x4 v[4]; float s = 0.f;
#pragma unroll
        for (int j = 0; j < 4; ++j) { v[j] = xr[64 * j]; s += (v[j].x * v[j].x + v[j].y * v[j].y) + (v[j].z * v[j].z + v[j].w * v[j].w); }
        s = wave_sum(s);
        u32x2* o8 = (u32x2*)(F.XN + (size_t)m * DM) + F.lane;
#pragma unroll
        for (int j = 0; j < 4; ++j) o8[64 * j] = (u32x2){cvtpk_g(v[j].x, v[j].y), cvtpk_g(v[j].z, v[j].w)};
        if (F.lane < 16) F.ST[(size_t)m * 16 + F.lane] = F.lane == 0 ? s : 0.f;
    }
    { f32x4* z = (f32x4*)(F.ST + (size_t)M * 16); const int n4 = 6 * M * 16 / 4;
      for (int i = gw * 64 + F.lane; i < n4; i += NGW * 64) z[i] = (f32x4){0.f, 0.f, 0.f, 0.f}; }
    for (int e = gw * 64 + F.lane; e < M * 16; e += NGW * 64) {
        const int row = e >> 4, i = e & 15;
        const float freq = exp2f(-(float)i * 0.83048202372184059f);
        const float ang = (float)F.pos[row] * freq;
        const float nrev = rintf(ang * 0.15915494309189535f);
        float r = fmaf(-nrev, 6.28125f, ang); r = fmaf(-nrev, 0.0019353071795864769f, r);
        const float rf = r * 0.15915494309189535f;
        F.CS[e] = (f32x2){__builtin_amdgcn_cosf(rf), __builtin_amdgcn_sinf(rf)};
    }
}

enum { G_ROWSCALE = 0, G_SWIGLU = 1, G_RESID = 2 };
struct GemmDesc { const bf16* A; const bf16* Bt; int N, K; int kind; int rmode; const float* stat; int nslots; float inv_dim; const float* base; float* xout; bf16* xn; float* stat_out; bf16* hout; };

__device__ __forceinline__ void naive_gemm_phase(const Frame& F, const GemmDesc g) {
    const int lane = F.lane, fr = lane & 15, fq = lane >> 4;
    const int gw = F.bid * NWAVES + F.wave, NGW = F.G * NWAVES;
    const int K = g.K;
    if (g.kind == G_SWIGLU) {
        const int ncb = FFH / 32, units = (M / 32) * ncb;
        for (int u = gw; u < units; u += NGW) {
            const int r0 = (u / ncb) * 32, j0 = (u % ncb) * 32;
            const int brow = (j0 >> 7) * 256 + (j0 & 127);
            f32x4 ag[2][2], au[2][2];
#pragma unroll
            for (int a = 0; a < 2; ++a)
#pragma unroll
                for (int b = 0; b < 2; ++b) { ag[a][b] = (f32x4){0.f, 0.f, 0.f, 0.f}; au[a][b] = (f32x4){0.f, 0.f, 0.f, 0.f}; }
            for (int k0 = 0; k0 < K; k0 += 32) {
                bf16x8 af[2], bg[2], bu[2];
#pragma unroll
                for (int a = 0; a < 2; ++a) af[a] = *(const bf16x8*)(g.A + (size_t)(r0 + 16 * a + fr) * K + k0 + 8 * fq);
#pragma unroll
                for (int b = 0; b < 2; ++b) { bg[b] = *(const bf16x8*)(g.Bt + (size_t)(brow + 16 * b + fr) * K + k0 + 8 * fq); bu[b] = *(const bf16x8*)(g.Bt + (size_t)(brow + 128 + 16 * b + fr) * K + k0 + 8 * fq); }
#pragma unroll
                for (int a = 0; a < 2; ++a)
#pragma unroll
                    for (int b = 0; b < 2; ++b) { ag[a][b] = __builtin_amdgcn_mfma_f32_16x16x32_bf16(af[a], bg[b], ag[a][b], 0, 0, 0); au[a][b] = __builtin_amdgcn_mfma_f32_16x16x32_bf16(af[a], bu[b], au[a][b], 0, 0, 0); }
            }
#pragma unroll
            for (int a = 0; a < 2; ++a)
#pragma unroll
                for (int r = 0; r < 4; ++r) { const int row = r0 + 16 * a + 4 * fq + r; const float rs = row_rstd(g.stat, row, g.nslots, g.inv_dim);
#pragma unroll
                    for (int b = 0; b < 2; ++b) { const float gv = ag[a][b][r] * rs, uv = au[a][b][r] * rs; const float hv = gv * uv / (1.0f + __builtin_amdgcn_exp2f(-gv * LOG2E));
                        g.hout[(size_t)row * FFH + j0 + 16 * b + fr] = (bf16)f2bf(hv); } }
        }
        return;
    }
    const int ncb = g.N / 64, units = (M / 32) * ncb;
    for (int u = gw; u < units; u += NGW) {
        const int r0 = (u / ncb) * 32, c0 = (u % ncb) * 64;
        f32x4 acc[2][4];
#pragma unroll
        for (int a = 0; a < 2; ++a)
#pragma unroll
            for (int b = 0; b < 4; ++b) acc[a][b] = (f32x4){0.f, 0.f, 0.f, 0.f};
        for (int k0 = 0; k0 < K; k0 += 32) {
            bf16x8 af[2], bfr[4];
#pragma unroll
            for (int a = 0; a < 2; ++a) af[a] = *(const bf16x8*)(g.A + (size_t)(r0 + 16 * a + fr) * K + k0 + 8 * fq);
#pragma unroll
            for (int b = 0; b < 4; ++b) bfr[b] = *(const bf16x8*)(g.Bt + (size_t)(c0 + 16 * b + fr) * K + k0 + 8 * fq);
#pragma unroll
            for (int a = 0; a < 2; ++a)
#pragma unroll
                for (int b = 0; b < 4; ++b) acc[a][b] = __builtin_amdgcn_mfma_f32_16x16x32_bf16(af[a], bfr[b], acc[a][b], 0, 0, 0);
        }
        if (g.kind == G_RESID) {
#pragma unroll
            for (int a = 0; a < 2; ++a)
#pragma unroll
                for (int r = 0; r < 4; ++r) { const int row = r0 + 16 * a + 4 * fq + r; float ss = 0.f;
#pragma unroll
                    for (int b = 0; b < 4; ++b) { const int col = c0 + 16 * b + fr; const size_t o = (size_t)row * DM + col; const float v = (g.base ? g.base[o] : bf2f(F.XN[o])) + acc[a][b][r]; if (g.xout) g.xout[o] = v; if (g.xn) g.xn[o] = (bf16)f2bf(v); ss += v * v; }
                    ss += __shfl_xor(ss, 1); ss += __shfl_xor(ss, 2); ss += __shfl_xor(ss, 4); ss += __shfl_xor(ss, 8);
                    if (fr == 0) atomicAdd(g.stat_out + (size_t)row * 16, ss); }
        } else {
            const int hh = c0 >> 7; const Route rt = route(F, g.rmode, hh); const int cin = c0 & 127;
            if (rt.wc0only && cin != 0) continue;
#pragma unroll
            for (int a = 0; a < 2; ++a)
#pragma unroll
                for (int r = 0; r < 4; ++r) { const int row = r0 + 16 * a + 4 * fq + r; const float rs = row_rstd(g.stat, row, g.nslots, g.inv_dim);
                    float v[4]; float ss = 0.f;
#pragma unroll
                    for (int b = 0; b < 4; ++b) { v[b] = acc[a][b][r] * rs; ss += v[b] * v[b]; }
                    if (rt.rope) { const f32x2 cs = F.CS[(size_t)row * 16 + fr];
#pragma unroll
                        for (int p = 0; p < 2; ++p) { const float x1 = v[2 * p], x2 = v[2 * p + 1]; v[2 * p] = x1 * cs.x - x2 * cs.y; v[2 * p + 1] = x2 * cs.x + x1 * cs.y; } }
#pragma unroll
                    for (int b = 0; b < 4; ++b) { if (rt.wc0only && b >= 2) break; rt.dst[(size_t)row * rt.pitch + rt.col + cin + 16 * b + fr] = (bf16)f2bf(v[b]); }
                    if (rt.stat) { ss += __shfl_xor(ss, 1); ss += __shfl_xor(ss, 2); ss += __shfl_xor(ss, 4); ss += __shfl_xor(ss, 8); if (fr == 0) atomicAdd(rt.stat + (size_t)row * 16, ss); } }
        }
    }
}

__device__ __forceinline__ float dot8(const float* q, const u32x4 c) {
    return q[0] * __builtin_bit_cast(float, c.x << 16) + q[1] * __builtin_bit_cast(float, c.x & 0xffff0000u) + q[2] * __builtin_bit_cast(float, c.y << 16) + q[3] * __builtin_bit_cast(float, c.y & 0xffff0000u)
         + q[4] * __builtin_bit_cast(float, c.z << 16) + q[5] * __builtin_bit_cast(float, c.z & 0xffff0000u) + q[6] * __builtin_bit_cast(float, c.w << 16) + q[7] * __builtin_bit_cast(float, c.w & 0xffff0000u);
}
__device__ __forceinline__ void axpy8(float* o, float al, float p, const u32x4 c) {
    o[0] = o[0] * al + p * __builtin_bit_cast(float, c.x << 16); o[1] = o[1] * al + p * __builtin_bit_cast(float, c.x & 0xffff0000u);
    o[2] = o[2] * al + p * __builtin_bit_cast(float, c.y << 16); o[3] = o[3] * al + p * __builtin_bit_cast(float, c.y & 0xffff0000u);
    o[4] = o[4] * al + p * __builtin_bit_cast(float, c.z << 16); o[5] = o[5] * al + p * __builtin_bit_cast(float, c.z & 0xffff0000u);
    o[6] = o[6] * al + p * __builtin_bit_cast(float, c.w << 16); o[7] = o[7] * al + p * __builtin_bit_cast(float, c.w & 0xffff0000u);
}
__device__ __forceinline__ void naive_sb(const Frame& F) {
    const int gw = F.bid * NWAVES + F.wave, NGW = F.G * NWAVES;
    for (int u = gw; u < BATCH * 8 * (SEQ / 64); u += NGW) {
        const int blk = u % (SEQ / 64), h = (u / (SEQ / 64)) % 8, b = u / (SEQ / 64 * 8);
        const int t = blk * 64 + F.lane; const size_t rowq = (size_t)b * SEQ + t;
        float q[64], o[64];
#pragma unroll
        for (int d = 0; d < 64; ++d) { q[d] = bf2f(F.QKV0[rowq * N0 + h * 64 + d]); o[d] = 0.f; }
        float carry = 0.f;
        for (int s = blk * 64 + 63; s >= 0; --s) {
            const bf16* kr = F.QKV0 + ((size_t)b * SEQ + s) * N0 + 512 + h * 64; const bf16* vr = kr + 512;
            float y = 0.f;
#pragma unroll
            for (int d = 0; d < 8; ++d) y += dot8(q + 8 * d, ((const u32x4*)kr)[d]);
            const bool valid = s < t;
            const float sp = fmaxf(y, 0.f) + __builtin_amdgcn_logf(1.0f + __builtin_amdgcn_exp2f(-fabsf(y)));
            const float w = valid ? __builtin_amdgcn_exp2f((y - sp) + carry) : 0.f;
            if (valid) carry -= sp;
#pragma unroll
            for (int d = 0; d < 8; ++d) axpy8(o + 8 * d, 1.0f, w, ((const u32x4*)vr)[d]);
        }
#pragma unroll
        for (int d = 0; d < 64; ++d) F.AO[rowq * DM + h * 64 + d] = (bf16)f2bf(o[d]);
    }
}
__device__ __forceinline__ float t5_bias2(const Frame& F, int rel, int h) {
    int bk = rel;
    if (rel >= 16) { bk = 16 + (int)(log2f((float)rel * 0.0625f) * (16.0f / 3.0f)); bk = bk > 31 ? 31 : bk; }
    return F.relb[bk * 8 + h] * LOG2E;
}
__device__ __forceinline__ void naive_swa(const Frame& F) {
    const int gw = F.bid * NWAVES + F.wave, NGW = F.G * NWAVES;
    for (int u = gw; u < BATCH * 8 * (SEQ / 64); u += NGW) {
        const int blk = u % (SEQ / 64), h = (u / (SEQ / 64)) % 8, b = u / (SEQ / 64 * 8), kvh = h >> 2;
        const int t = blk * 64 + F.lane; const size_t rowq = (size_t)b * SEQ + t;
        float q[64], o[64];
#pragma unroll
        for (int d = 0; d < 64; ++d) { q[d] = bf2f(F.QKV0[rowq * N0 + 1536 + h * 64 + d]); o[d] = 0.f; }
        float m = F.sinks[h] * LOG2E, l = 1.0f;
        const int s_lo = blk * 64 - 127 < 0 ? 0 : blk * 64 - 127;
        for (int s = s_lo; s <= blk * 64 + 63; ++s) {
            const bf16* kr = F.QKV0 + ((size_t)b * SEQ + s) * N0 + 2048 + kvh * 64; const bf16* vr = kr + 128;
            float y = 0.f;
#pragma unroll
            for (int d = 0; d < 8; ++d) y += dot8(q + 8 * d, ((const u32x4*)kr)[d]);
            const int rel = t - s; const bool valid = rel >= 0 && rel < 128;
            const float lg = valid ? y + t5_bias2(F, rel & 127, h) : -INFINITY;
            const float mn = fmaxf(m, lg), al = __builtin_amdgcn_exp2f(m - mn), p = __builtin_amdgcn_exp2f(lg - mn);
            l = l * al + p; m = mn;
#pragma unroll
            for (int d = 0; d < 8; ++d) axpy8(o + 8 * d, al, p, ((const u32x4*)vr)[d]);
        }
        const float il = 1.0f / l;
#pragma unroll
        for (int d = 0; d < 64; ++d) F.AO[rowq * DM + 512 + h * 64 + d] = (bf16)f2bf(o[d] * il);
    }
}
__device__ __forceinline__ void naive_mla(const Frame& F) {
    const int gw = F.bid * NWAVES + F.wave, NGW = F.G * NWAVES;
    for (int u = gw; u < BATCH * 16 * (SEQ / 64); u += NGW) {
        const int blk = (SEQ / 64 - 1) - u % (SEQ / 64), h = (u / (SEQ / 64)) % 16, b = u / (SEQ / 64 * 16);
        const int t = blk * 64 + F.lane; const size_t rowq = (size_t)b * SEQ + t;
        float q[96], o[64];
#pragma unroll
        for (int d = 0; d < 64; ++d) { q[d] = bf2f(F.QN[rowq * 1024 + h * 64 + d]); o[d] = 0.f; }
#pragma unroll
        for (int d = 0; d < 32; ++d) q[64 + d] = bf2f(F.QR[rowq * 512 + h * 32 + d]);
        float m = -1e30f, l = 0.f;
        for (int s = 0; s <= blk * 64 + 63; ++s) {
            const size_t rk = (size_t)b * SEQ + s; const bf16* kn = F.KN + rk * 1024 + h * 64; const bf16* kr = F.KR + rk * 32; const bf16* vr = F.VV + rk * 1024 + h * 64;
            float y = 0.f;
#pragma unroll
            for (int d = 0; d < 8; ++d) y += dot8(q + 8 * d, ((const u32x4*)kn)[d]);
#pragma unroll
            for (int d = 0; d < 4; ++d) y += dot8(q + 64 + 8 * d, ((const u32x4*)kr)[d]);
            const float lg = s <= t ? y : -INFINITY;
            const float mn = fmaxf(m, lg), al = __builtin_amdgcn_exp2f(m - mn), p = __builtin_amdgcn_exp2f(lg - mn);
            l = l * al + p; m = mn;
#pragma unroll
            for (int d = 0; d < 8; ++d) axpy8(o + 8 * d, al, p, ((const u32x4*)vr)[d]);
        }
        const float il = 1.0f / l;
#pragma unroll
        for (int d = 0; d < 64; ++d) F.AO[rowq * DM + h * 64 + d] = (bf16)f2bf(o[d] * il);
    }
}
__device__ __forceinline__ void final_norm_phase(const Frame& F) {
    const int gw = F.bid * NWAVES + F.wave, NGW = F.G * NWAVES;
    for (int m = gw; m < M; m += NGW) {
        const float rs = row_rstd(F.ST + (size_t)4 * M * 16, m, 16, 1.0f / DM);
        f32x4* xr = (f32x4*)(F.out + (size_t)m * DM) + F.lane; const f32x4* gr = (const f32x4*)F.final_norm + F.lane;
#pragma unroll
        for (int j = 0; j < 4; ++j) { const f32x4 v = xr[64 * j], g = gr[64 * j]; xr[64 * j] = v * rs * g; }
    }
}

namespace att {
typedef float f32x16 __attribute__((ext_vector_type(16)));
typedef short v4i16_t __attribute__((ext_vector_type(4)));
typedef __bf16 bf16x2_t __attribute__((ext_vector_type(2)));
constexpr int NSLOT = 3, SLOT_K = 12288, SLOT_V = 8192, OFF_K = 0, OFF_V = NSLOT * SLOT_K, OFF_FLAG = OFF_V + NSLOT * SLOT_V, OFF_TB = OFF_FLAG + 64, ATT_LDS = OFF_TB + 512;
__device__ __forceinline__ unsigned cvtpk(float lo, float hi) { f32x2 v = {lo, hi}; bf16x2_t b = __builtin_convertvector(v, bf16x2_t); return __builtin_bit_cast(unsigned, b); }
__device__ __forceinline__ void glds16(const void* gsrc, unsigned lds_dst) { unsigned keep;
    asm volatile("s_mov_b32 %0, m0\n\ts_mov_b32 m0, %2\n\ts_nop 0\n\tglobal_load_lds_dwordx4 %1, off\n\ts_mov_b32 m0, %0" : "=&s"(keep) : "v"(gsrc), "s"(lds_dst) : "memory"); }
#define ATT_WAIT_BAR(N) asm volatile("s_waitcnt vmcnt(" #N ") lgkmcnt(0)\n\ts_barrier" ::: "memory")
__device__ __forceinline__ int crow(int r, int hi) { return (r & 3) + 8 * (r >> 2) + 4 * hi; }

template <int MODE> __device__ __forceinline__ void attn_unit(const Frame& F, LAS unsigned char* lds, int b, int h, int qb) {
    const int tid = F.tid, lane = F.lane, wid = F.wave, r32 = lane & 31, hi = lane >> 5;
    constexpr int ND2 = MODE == 2 ? 6 : 4;
    const int q0 = qb * 256, qw0 = q0 + 32 * wid, qg = qw0 + r32;
    const size_t rowq = (size_t)b * SEQ + qg, rowb = (size_t)b * SEQ;
    const bf16 *Qp, *Qr = nullptr, *Kb, *Vb, *KRb = nullptr; int pK, pV; bf16* Op;
    if (MODE == 0) { Qp = F.QKV0 + rowq * N0 + h * 64; Kb = F.QKV0 + rowb * N0 + 512 + h * 64; Vb = Kb + 512; pK = pV = N0; Op = F.AO + rowq * DM + h * 64; }
    else if (MODE == 1) { Qp = F.QKV0 + rowq * N0 + 1536 + h * 64; Kb = F.QKV0 + rowb * N0 + 2048 + (h >> 2) * 64; Vb = Kb + 128; pK = pV = N0; Op = F.AO + rowq * DM + 512 + h * 64; }
    else { Qp = F.QN + rowq * 1024 + h * 64; Qr = F.QR + rowq * 512 + h * 32; Kb = F.KN + rowb * 1024 + h * 64; KRb = F.KR + rowb * 32; Vb = F.VV + rowb * 1024 + h * 64; pK = pV = 1024; Op = F.AO + rowq * DM + h * 64; }
    int t_first, t_step, NT;
    if (MODE == 0) { t_first = q0 / 64 + 3; t_step = -1; NT = q0 / 64 + 4; }
    else if (MODE == 1) { const int tlo = q0 / 64 - 2 < 0 ? 0 : q0 / 64 - 2; t_first = tlo; t_step = 1; NT = q0 / 64 + 4 - tlo; }
    else { t_first = 0; t_step = 1; NT = q0 / 64 + 4; }
    const bf16* ksrc = Kb + (size_t)lane * pK + wid * 8;
    const bf16* krsrc = MODE == 2 ? KRb + (size_t)lane * 32 + (wid & 3) * 8 : nullptr;
    const bf16* vsrc = Vb + (size_t)(16 * (wid & 3) + (lane >> 2)) * pV + (wid >> 2) * 32 + (lane & 3) * 8;
    const unsigned lds0 = (unsigned)(uintptr_t)lds;
#define ATT_ISSUE(ti, slot) do { const int kb_ = 64 * (ti); const unsigned so_ = (unsigned)(slot); \
        glds16(ksrc + (size_t)kb_ * pK, (unsigned)__builtin_amdgcn_readfirstlane(lds0 + OFF_K + so_ * SLOT_K + wid * 1024)); \
        if (MODE == 2 && wid < 4) glds16(krsrc + (size_t)kb_ * 32, (unsigned)__builtin_amdgcn_readfirstlane(lds0 + OFF_K + so_ * SLOT_K + (8 + wid) * 1024)); \
        glds16(vsrc + (size_t)kb_ * pV, (unsigned)__builtin_amdgcn_readfirstlane(lds0 + OFF_V + so_ * SLOT_V + wid * 1024)); } while (0)
    ATT_ISSUE(t_first, 0);
    if (NT > 1) ATT_ISSUE(t_first + t_step, 1);
    bf16x8 qr[ND2];
#pragma unroll
    for (int c2 = 0; c2 < 4; ++c2) qr[c2] = *(const bf16x8*)(Qp + 16 * c2 + 8 * hi);
    if (MODE == 2) { qr[ND2 - 2] = *(const bf16x8*)(Qr + 8 * hi); qr[ND2 - 1] = *(const bf16x8*)(Qr + 16 + 8 * hi); }
    LAS float* tb = (LAS float*)(lds + OFF_TB);
    volatile LAS unsigned* flg = (volatile LAS unsigned*)(lds + OFF_FLAG);
    if (MODE == 1 && tid < 128) tb[tid] = t5_bias2(F, tid, h);
    f32x16 o[2]; o[0] = f32x16{}; o[1] = f32x16{};
    float m_run = MODE == 1 ? F.sinks[h] * LOG2E : -1e30f, l_run = (MODE == 1 && hi == 0) ? 1.0f : 0.0f, C = 1.0f;
    const LAS unsigned char* kp0 = lds + OFF_K + hi * 1024 + r32 * 16;
    const LAS unsigned char* vp0 = lds + OFF_V + ((lane >> 4) & 1) * 32 + (lane & 3) * 8 + (4 * hi + ((lane & 15) >> 2)) * 64;
    int slot = 0;
    for (int i = 0; i < NT; ++i) {
        if (i == 0 || i + 1 >= NT) ATT_WAIT_BAR(0);
        else if (MODE == 2 && wid < 4) ATT_WAIT_BAR(3);
        else ATT_WAIT_BAR(2);
        if (MODE == 0 && i > 0) { const LAS unsigned* fp = (const LAS unsigned*)(lds + OFF_FLAG) + ((i - 1) & 1) * 8; unsigned a = 1u;
#pragma unroll
            for (int w = 0; w < 8; ++w) a &= fp[w];
            if (__builtin_amdgcn_readfirstlane(a)) break; }
        if (i + 2 < NT) ATT_ISSUE(t_first + (i + 2) * t_step, slot == 0 ? 2 : slot - 1);
        const int kb = 64 * (t_first + i * t_step);
        bool skip, need_mask;
        if (MODE == 0) { skip = kb >= qw0 + 31; need_mask = kb + 63 >= qw0; }
        else if (MODE == 1) { skip = kb > qw0 + 31 || kb + 63 < qw0 - 127; need_mask = true; }
        else { skip = kb > qw0 + 31; need_mask = kb + 63 > qw0; }
        if (!skip) {
            f32x16 s0 = f32x16{}, s1 = f32x16{};
            const LAS unsigned char* kp = kp0 + slot * SLOT_K;
#pragma unroll
            for (int c2 = 0; c2 < ND2; ++c2) {
                const bf16x8 k0 = *(const LAS bf16x8*)(kp + c2 * 2048), k1 = *(const LAS bf16x8*)(kp + c2 * 2048 + 512);
                s0 = __builtin_amdgcn_mfma_f32_32x32x16_bf16(k0, qr[c2], s0, 0, 0, 0);
                s1 = __builtin_amdgcn_mfma_f32_32x32x16_bf16(k1, qr[c2], s1, 0, 0, 0);
            }
            u32x4 pw[4];
            if (MODE == 0) {
                float om[32], be[32];
#pragma unroll
                for (int r = 0; r < 16; ++r) {
                    { const float e = __builtin_amdgcn_exp2f(fminf(s0[r], 64.0f)), d = __builtin_amdgcn_rcpf(1.0f + e); om[r] = d; be[r] = e * d; }
                    { const float e = __builtin_amdgcn_exp2f(fminf(s1[r], 64.0f)), d = __builtin_amdgcn_rcpf(1.0f + e); om[16 + r] = d; be[16 + r] = e * d; }
                }
                if (need_mask) {
#pragma unroll
                    for (int r = 0; r < 16; ++r) { const int key = kb + crow(r, hi);
                        if (key >= qg) { om[r] = 1.0f; be[r] = 0.0f; }
                        if (key + 32 >= qg) { om[16 + r] = 1.0f; be[16 + r] = 0.0f; } }
                }
                float ga[8], gb[8];
#pragma unroll
                for (int gi = 0; gi < 8; ++gi) { const float gp = (om[4 * gi] * om[4 * gi + 1]) * (om[4 * gi + 2] * om[4 * gi + 3]);
                    const auto rr = __builtin_amdgcn_permlane32_swap(__float_as_uint(gp), __float_as_uint(gp), false, false); ga[gi] = __uint_as_float(rr[0]); gb[gi] = __uint_as_float(rr[1]); }
                float R = C, Rm[8];
#pragma unroll
                for (int gi = 7; gi >= 0; --gi) { const float Rb = R; R *= gb[gi]; const float Ra = R; R *= ga[gi]; Rm[gi] = hi ? Rb : Ra; }
                C = R;
#pragma unroll
                for (int gi = 0; gi < 8; ++gi) { float P = Rm[gi];
                    be[4 * gi + 3] *= P; P *= om[4 * gi + 3]; be[4 * gi + 2] *= P; P *= om[4 * gi + 2]; be[4 * gi + 1] *= P; P *= om[4 * gi + 1]; be[4 * gi] *= P; }
#pragma unroll
                for (int k = 0; k < 4; ++k) pw[k] = (u32x4){cvtpk(be[8 * k], be[8 * k + 1]), cvtpk(be[8 * k + 2], be[8 * k + 3]), cvtpk(be[8 * k + 4], be[8 * k + 5]), cvtpk(be[8 * k + 6], be[8 * k + 7])};
            } else {
                if (MODE == 1) {
#pragma unroll
                    for (int r = 0; r < 16; ++r) { const int rel = qg - (kb + crow(r, hi));
                        s0[r] = (rel >= 0 && rel < 128) ? s0[r] + tb[rel & 127] : -INFINITY;
                        s1[r] = (rel - 32 >= 0 && rel - 32 < 128) ? s1[r] + tb[(rel - 32) & 127] : -INFINITY; }
                } else if (need_mask) {
#pragma unroll
                    for (int r = 0; r < 16; ++r) { const int key = kb + crow(r, hi); if (key > qg) s0[r] = -INFINITY; if (key + 32 > qg) s1[r] = -INFINITY; }
                }
                float mx = fmaxf(s0[0], s1[0]);
#pragma unroll
                for (int r = 1; r < 16; ++r) mx = fmaxf(mx, fmaxf(s0[r], s1[r]));
                { const auto rr = __builtin_amdgcn_permlane32_swap(__float_as_uint(mx), __float_as_uint(mx), false, false); mx = fmaxf(__uint_as_float(rr[0]), __uint_as_float(rr[1])); }
                const float mn = fmaxf(m_run, mx);
                if (__any(mn > m_run)) { const float al = __builtin_amdgcn_exp2f(m_run - mn); l_run *= al; m_run = mn;
#pragma unroll
                    for (int r = 0; r < 16; ++r) { o[0][r] *= al; o[1][r] *= al; } }
                float ls = 0.f;
#pragma unroll
                for (int r = 0; r < 16; ++r) { s0[r] = __builtin_amdgcn_exp2f(s0[r] - m_run); s1[r] = __builtin_amdgcn_exp2f(s1[r] - m_run); ls += s0[r] + s1[r]; }
                l_run += ls;
                pw[0] = (u32x4){cvtpk(s0[0], s0[1]), cvtpk(s0[2], s0[3]), cvtpk(s0[4], s0[5]), cvtpk(s0[6], s0[7])};
                pw[1] = (u32x4){cvtpk(s0[8], s0[9]), cvtpk(s0[10], s0[11]), cvtpk(s0[12], s0[13]), cvtpk(s0[14], s0[15])};
                pw[2] = (u32x4){cvtpk(s1[0], s1[1]), cvtpk(s1[2], s1[3]), cvtpk(s1[4], s1[5]), cvtpk(s1[6], s1[7])};
                pw[3] = (u32x4){cvtpk(s1[8], s1[9]), cvtpk(s1[10], s1[11]), cvtpk(s1[12], s1[13]), cvtpk(s1[14], s1[15])};
            }
            const LAS unsigned char* vp = vp0 + slot * SLOT_V;
#pragma unroll
            for (int dh = 0; dh < 2; ++dh)
#pragma unroll
                for (int ks = 0; ks < 4; ++ks) {
                    const v4i16_t lo = __builtin_amdgcn_ds_read_tr16_b64_v4i16((LAS v4i16_t*)(vp + dh * 4096 + ks * 1024));
                    const v4i16_t hi4 = __builtin_amdgcn_ds_read_tr16_b64_v4i16((LAS v4i16_t*)(vp + dh * 4096 + ks * 1024 + 512));
                    const bf16x8 vf = (bf16x8){lo[0], lo[1], lo[2], lo[3], hi4[0], hi4[1], hi4[2], hi4[3]};
                    o[dh] = __builtin_amdgcn_mfma_f32_32x32x16_bf16(vf, __builtin_bit_cast(bf16x8, pw[ks]), o[dh], 0, 0, 0);
                }
        }
        if (MODE == 0) { const unsigned small = __all(C < 1.17549435e-38f) ? 1u : 0u; if (lane == 0) flg[(i & 1) * 8 + wid] = small; }
        slot = slot == 2 ? 0 : slot + 1;
    }
    float sc = 1.0f;
    if (MODE != 0) { const auto rr = __builtin_amdgcn_permlane32_swap(__float_as_uint(l_run), __float_as_uint(l_run), false, false); sc = 1.0f / (__uint_as_float(rr[0]) + __uint_as_float(rr[1])); }
#pragma unroll
    for (int dh = 0; dh < 2; ++dh)
#pragma unroll
        for (int g = 0; g < 4; ++g)
            *(u32x2*)(Op + 32 * dh + 8 * g + 4 * hi) = (u32x2){cvtpk(o[dh][4 * g] * sc, o[dh][4 * g + 1] * sc), cvtpk(o[dh][4 * g + 2] * sc, o[dh][4 * g + 3] * sc)};
    ATT_WAIT_BAR(0);
#undef ATT_ISSUE
}

constexpr int MSLOT = 20480, MKV = 12288, MNS = 4;
template <bool MASK>
__device__ __forceinline__ void mla_step(u32x4 (&pw)[4], f32x16 (&o)[2], f32x16& negm, float& m_run, float& l_run, const bf16x8 (&qr)[6],
                                         const LAS unsigned char* kp, const LAS unsigned char* vp, int kb, int qg, int hi) {
    constexpr float THRL = 8.0f;
    __builtin_amdgcn_sched_barrier(0);
    f32x16 S0 = negm, S1 = negm;
#pragma unroll
    for (int c2 = 0; c2 < 6; ++c2) {
        const bf16x8 k0 = *(const LAS bf16x8*)(kp + c2 * 2048), k1 = *(const LAS bf16x8*)(kp + c2 * 2048 + 512);
        S0 = __builtin_amdgcn_mfma_f32_32x32x16_bf16(k0, qr[c2], S0, 0, 0, 0);
        S1 = __builtin_amdgcn_mfma_f32_32x32x16_bf16(k1, qr[c2], S1, 0, 0, 0);
    }
    __builtin_amdgcn_sched_barrier(0);
    if (MASK) {
#pragma unroll
        for (int r = 0; r < 16; ++r) { const int key = kb + crow(r, hi); if (key > qg) S0[r] = -INFINITY; if (key + 32 > qg) S1[r] = -INFINITY; }
    }
    float mx = __builtin_fmaxf(__builtin_fmaxf(S0[0], S0[1]), S1[0]), my = __builtin_fmaxf(__builtin_fmaxf(S0[2], S0[3]), S1[1]);
    mx = __builtin_fmaxf(__builtin_fmaxf(mx, S1[2]), S1[3]);
#pragma unroll
    for (int r = 4; r < 16; r += 4) { mx = __builtin_fmaxf(__builtin_fmaxf(mx, S0[r]), S0[r + 1]); my = __builtin_fmaxf(__builtin_fmaxf(my, S0[r + 2]), S0[r + 3]);
        mx = __builtin_fmaxf(__builtin_fmaxf(mx, S1[r]), S1[r + 1]); my = __builtin_fmaxf(__builtin_fmaxf(my, S1[r + 2]), S1[r + 3]); }
    mx = __builtin_fmaxf(mx, my);
    { const auto rr = __builtin_amdgcn_permlane32_swap(__float_as_uint(mx), __float_as_uint(mx), false, false); mx = __builtin_fmaxf(__uint_as_float(rr[0]), __uint_as_float(rr[1])); }
    bool resc = false; float f = 1.0f;
    if (__any(mx > THRL)) {
        const float dl = __builtin_fmaxf(mx, 0.f); m_run += dl; f = __builtin_amdgcn_exp2f(-dl); l_run *= f; resc = true;
#pragma unroll
        for (int r = 0; r < 16; ++r) { S0[r] -= dl; S1[r] -= dl; negm[r] = -m_run; }
    }
    __builtin_amdgcn_sched_barrier(0);
#pragma unroll
    for (int dh = 0; dh < 2; ++dh)
#pragma unroll
        for (int ks = 0; ks < 4; ++ks) {
            const v4i16_t lo = __builtin_amdgcn_ds_read_tr16_b64_v4i16((LAS v4i16_t*)(vp + dh * 4096 + ks * 1024));
            const v4i16_t hi4 = __builtin_amdgcn_ds_read_tr16_b64_v4i16((LAS v4i16_t*)(vp + dh * 4096 + ks * 1024 + 512));
            const bf16x8 vf = (bf16x8){lo[0], lo[1], lo[2], lo[3], hi4[0], hi4[1], hi4[2], hi4[3]};
            o[dh] = __builtin_amdgcn_mfma_f32_32x32x16_bf16(vf, __builtin_bit_cast(bf16x8, pw[ks]), o[dh], 0, 0, 0);
        }
    float la = 0.f, lb = 0.f, lc = 0.f, ld = 0.f;
#pragma unroll
    for (int r = 0; r < 16; ++r) { S0[r] = __builtin_amdgcn_exp2f(S0[r]); S1[r] = __builtin_amdgcn_exp2f(S1[r]); }
#pragma unroll
    for (int r = 0; r < 16; r += 4) { la += S0[r]; lb += S0[r + 1]; lc += S0[r + 2]; ld += S0[r + 3]; la += S1[r]; lb += S1[r + 1]; lc += S1[r + 2]; ld += S1[r + 3]; }
    l_run += (la + lb) + (lc + ld);
    u32x4 pn[4];
    pn[0] = (u32x4){cvtpk(S0[0], S0[1]), cvtpk(S0[2], S0[3]), cvtpk(S0[4], S0[5]), cvtpk(S0[6], S0[7])};
    pn[1] = (u32x4){cvtpk(S0[8], S0[9]), cvtpk(S0[10], S0[11]), cvtpk(S0[12], S0[13]), cvtpk(S0[14], S0[15])};
    pn[2] = (u32x4){cvtpk(S1[0], S1[1]), cvtpk(S1[2], S1[3]), cvtpk(S1[4], S1[5]), cvtpk(S1[6], S1[7])};
    pn[3] = (u32x4){cvtpk(S1[8], S1[9]), cvtpk(S1[10], S1[11]), cvtpk(S1[12], S1[13]), cvtpk(S1[14], S1[15])};
    __builtin_amdgcn_sched_group_barrier(0x100, 4, 0);
#pragma unroll
    for (int i = 0; i < 8; ++i) { __builtin_amdgcn_sched_group_barrier(0x008, 1, 0); if (i < 6) __builtin_amdgcn_sched_group_barrier(0x100, 2, 0); __builtin_amdgcn_sched_group_barrier(0x002, 10, 0); }
    __builtin_amdgcn_sched_barrier(0);
    pw[0] = pn[0]; pw[1] = pn[1]; pw[2] = pn[2]; pw[3] = pn[3];
    if (resc) {
#pragma unroll
        for (int r = 0; r < 16; ++r) { o[0][r] *= f; o[1][r] *= f; }
    }
}
__device__ __forceinline__ void mla_unit(const Frame& F, LAS unsigned char* lds, int b, int h, int qb) {
    const int lane = F.lane, wid = F.wave, r32 = lane & 31, hi = lane >> 5;
    const int q0 = qb * 256, qw0 = q0 + 32 * wid, qg = qw0 + r32;
    const size_t rowq = (size_t)b * SEQ + qg, rowb = (size_t)b * SEQ;
    const bf16* Qp = F.QN + rowq * 1024 + h * 64; const bf16* Qr = F.QR + rowq * 512 + h * 32;
    const bf16* Kb = F.KN + rowb * 1024 + h * 64; const bf16* KRb = F.KR + rowb * 32; const bf16* Vb = F.VV + rowb * 1024 + h * 64; bf16* Op = F.AO + rowq * DM + h * 64;
    const int NT = q0 / 64 + 4;
    const bf16* ksrc = Kb + (size_t)lane * 1024 + wid * 8;
    const bf16* krsrc = KRb + (size_t)lane * 32 + (wid & 3) * 8;
    const bf16* vsrc = Vb + (size_t)(16 * (wid & 3) + (lane >> 2)) * 1024 + (wid >> 2) * 32 + (lane & 3) * 8;
    const unsigned lds0 = (unsigned)(uintptr_t)lds;
#define MLA_ISSUE(ti) do { const int kb_ = 64 * (ti); const unsigned so_ = lds0 + (unsigned)((ti) & 3) * MSLOT; \
        glds16(ksrc + (size_t)kb_ * 1024, (unsigned)__builtin_amdgcn_readfirstlane(so_ + wid * 1024)); \
        if (wid < 4) glds16(krsrc + (size_t)kb_ * 32, (unsigned)__builtin_amdgcn_readfirstlane(so_ + (8 + wid) * 1024)); \
        glds16(vsrc + (size_t)kb_ * 1024, (unsigned)__builtin_amdgcn_readfirstlane(so_ + MKV + wid * 1024)); } while (0)
#define MLA_WAIT(t) do { if ((t) + 1 >= NT) ATT_WAIT_BAR(0); else if (wid < 4) ATT_WAIT_BAR(3); else ATT_WAIT_BAR(2); } while (0)
    MLA_ISSUE(0); MLA_ISSUE(1); MLA_ISSUE(2);
    bf16x8 qr[6];
#pragma unroll
    for (int c2 = 0; c2 < 4; ++c2) qr[c2] = *(const bf16x8*)(Qp + 16 * c2 + 8 * hi);
    qr[4] = *(const bf16x8*)(Qr + 8 * hi); qr[5] = *(const bf16x8*)(Qr + 16 + 8 * hi);
    const LAS unsigned char* kp0 = lds + hi * 1024 + r32 * 16;
    const LAS unsigned char* vp0 = lds + MKV + ((lane >> 4) & 1) * 32 + (lane & 3) * 8 + (4 * hi + ((lane & 15) >> 2)) * 64;
    f32x16 o[2]; o[0] = f32x16{}; o[1] = f32x16{};
    f32x16 negm; u32x4 pw[4];
    float m_run, l_run = 0.f;
    ATT_WAIT_BAR(0);
    {
        f32x16 pA0 = f32x16{}, pA1 = f32x16{};
#pragma unroll
        for (int c2 = 0; c2 < 6; ++c2) {
            const bf16x8 k0 = *(const LAS bf16x8*)(kp0 + c2 * 2048), k1 = *(const LAS bf16x8*)(kp0 + c2 * 2048 + 512);
            pA0 = __builtin_amdgcn_mfma_f32_32x32x16_bf16(k0, qr[c2], pA0, 0, 0, 0);
            pA1 = __builtin_amdgcn_mfma_f32_32x32x16_bf16(k1, qr[c2], pA1, 0, 0, 0);
        }
        if (63 > qw0) {
#pragma unroll
            for (int r = 0; r < 16; ++r) { const int key = crow(r, hi); if (key > qg) pA0[r] = -INFINITY; if (key + 32 > qg) pA1[r] = -INFINITY; }
        }
        float mx = __builtin_fmaxf(pA0[0], pA1[0]);
#pragma unroll
        for (int r = 1; r < 16; ++r) mx = __builtin_fmaxf(mx, __builtin_fmaxf(pA0[r], pA1[r]));
        { const auto rr = __builtin_amdgcn_permlane32_swap(__float_as_uint(mx), __float_as_uint(mx), false, false); mx = __builtin_fmaxf(__uint_as_float(rr[0]), __uint_as_float(rr[1])); }
        m_run = mx; float ls = 0.f;
#pragma unroll
        for (int r = 0; r < 16; ++r) { pA0[r] = __builtin_amdgcn_exp2f(pA0[r] - mx); pA1[r] = __builtin_amdgcn_exp2f(pA1[r] - mx); negm[r] = -mx; ls += pA0[r] + pA1[r]; }
        l_run = ls;
        pw[0] = (u32x4){cvtpk(pA0[0], pA0[1]), cvtpk(pA0[2], pA0[3]), cvtpk(pA0[4], pA0[5]), cvtpk(pA0[6], pA0[7])};
        pw[1] = (u32x4){cvtpk(pA0[8], pA0[9]), cvtpk(pA0[10], pA0[11]), cvtpk(pA0[12], pA0[13]), cvtpk(pA0[14], pA0[15])};
        pw[2] = (u32x4){cvtpk(pA1[0], pA1[1]), cvtpk(pA1[2], pA1[3]), cvtpk(pA1[4], pA1[5]), cvtpk(pA1[6], pA1[7])};
        pw[3] = (u32x4){cvtpk(pA1[8], pA1[9]), cvtpk(pA1[10], pA1[11]), cvtpk(pA1[12], pA1[13]), cvtpk(pA1[14], pA1[15])};
    }
    int t = 1;
    for (; t < NT - 4; ++t) {
        MLA_WAIT(t); if (t + 2 < NT) MLA_ISSUE(t + 2);
        mla_step<false>(pw, o, negm, m_run, l_run, qr, kp0 + (t & 3) * MSLOT, vp0 + ((t - 1) & 3) * MSLOT, 64 * t, qg, hi);
    }
    for (; t < NT; ++t) {
        MLA_WAIT(t); if (t + 2 < NT) MLA_ISSUE(t + 2);
        mla_step<true>(pw, o, negm, m_run, l_run, qr, kp0 + (t & 3) * MSLOT, vp0 + ((t - 1) & 3) * MSLOT, 64 * t, qg, hi);
    }
    {
        const LAS unsigned char* vp = vp0 + ((NT - 1) & 3) * MSLOT;
#pragma unroll
        for (int dh = 0; dh < 2; ++dh)
#pragma unroll
            for (int ks = 0; ks < 4; ++ks) {
                const v4i16_t lo = __builtin_amdgcn_ds_read_tr16_b64_v4i16((LAS v4i16_t*)(vp + dh * 4096 + ks * 1024));
                const v4i16_t hi4 = __builtin_amdgcn_ds_read_tr16_b64_v4i16((LAS v4i16_t*)(vp + dh * 4096 + ks * 1024 + 512));
                const bf16x8 vf = (bf16x8){lo[0], lo[1], lo[2], lo[3], hi4[0], hi4[1], hi4[2], hi4[3]};
                o[dh] = __builtin_amdgcn_mfma_f32_32x32x16_bf16(vf, __builtin_bit_cast(bf16x8, pw[ks]), o[dh], 0, 0, 0);
            }
    }
    float sc;
    { const auto rr = __builtin_amdgcn_permlane32_swap(__float_as_uint(l_run), __float_as_uint(l_run), false, false); sc = 1.0f / (__uint_as_float(rr[0]) + __uint_as_float(rr[1])); }
#pragma unroll
    for (int dh = 0; dh < 2; ++dh)
#pragma unroll
        for (int g = 0; g < 4; ++g)
            *(u32x2*)(Op + 32 * dh + 8 * g + 4 * hi) = (u32x2){cvtpk(o[dh][4 * g] * sc, o[dh][4 * g + 1] * sc), cvtpk(o[dh][4 * g + 2] * sc, o[dh][4 * g + 3] * sc)};
    ATT_WAIT_BAR(0);
#undef MLA_ISSUE
#undef MLA_WAIT
}
__device__ __forceinline__ void attn0_phase(const Frame& F, LAS unsigned char* lds) {
    const int vcu = (F.G % 8 == 0) ? (F.bid % 8) * (F.G / 8) + F.bid / 8 : F.bid;
    for (int p = vcu; p < 256; p += F.G) { const int bh = p >> 3, s = p & 7, b = bh >> 3, h = bh & 7;
#if USE_FAST_SB
        for (int k = 0; k < 2; ++k) attn_unit<0>(F, lds, b, h, k ? s : 15 - s);
#endif
#if USE_FAST_SWA
        for (int k = 0; k < 2; ++k) attn_unit<1>(F, lds, b, h, k ? s : 15 - s);
#endif
    }
}
__device__ __forceinline__ void attn1_phase(const Frame& F, LAS unsigned char* lds) {
    const int vcu = (F.G % 8 == 0) ? (F.bid % 8) * (F.G / 8) + F.bid / 8 : F.bid;
    for (int p = vcu; p < 256; p += F.G) { const int bh = p >> 2, s = p & 3, b = bh >> 4, h = bh & 15;
        for (int k = 0; k < 4; ++k) mla_unit(F, lds, b, h, k == 0 ? 15 - s : (k == 1 ? 11 - s : (k == 2 ? 4 + s : s))); }
}
}

#define RLX_AGENT __ATOMIC_RELAXED, __HIP_MEMORY_SCOPE_AGENT
#define XB_TMO      128
#define XB_XCNT(j)  (256  + 64 * (j))
#define XB_XSUB(j)  (1280 + 64 * (j))
#define XB_XGEN(j)  (2304 + 64 * (j))
#define XB_TOP      3328
#define XB_TOPGEN   3392
#define XCD_BAR_WORDS 3456
#define XB_SPIN_CAP (1u << 22)
__device__ __forceinline__ unsigned xb_ld(unsigned* p)              { return __hip_atomic_load(p, __ATOMIC_RELAXED, __HIP_MEMORY_SCOPE_AGENT); }
__device__ __forceinline__ unsigned xb_add(unsigned* p, unsigned v) { return __hip_atomic_fetch_add(p, v, __ATOMIC_RELAXED, __HIP_MEMORY_SCOPE_AGENT); }
__device__ __forceinline__ unsigned xb_xcc_id() { return (unsigned)__builtin_amdgcn_s_getreg((3 << 11) | 20) & 0xFu; }
#define XB_SPIN(cond, bar) do { unsigned _sp = 0; while (cond) { __builtin_amdgcn_s_sleep(1); \
    if ((++_sp & 255u) == 0u) { if (xb_ld(&(bar)[XB_TMO])) break; if (_sp > XB_SPIN_CAP) { atomicAdd(&(bar)[XB_TMO], 1u); break; } } } } while (0)
struct XcdBarrier { unsigned* bar; unsigned x; volatile LAS unsigned* st; };
__device__ __forceinline__ XcdBarrier xcd_barrier_post(unsigned* bar, volatile LAS unsigned* st) {
    XcdBarrier b; b.bar = bar; b.x = xb_xcc_id(); b.st = st;
    if (threadIdx.x == 0) (void)xb_add(&bar[XB_XCNT(b.x)], 1u);
    return b;
}
__device__ __forceinline__ void xcd_barrier_complete(unsigned* bar, unsigned x, unsigned& nloc, unsigned& nx) {
    const unsigned G = gridDim.x * gridDim.y * gridDim.z;
    unsigned sum, cnt, mine, sp = 0u;
    for (;;) {
        sum = 0u; cnt = 0u; mine = 0u;
#pragma unroll
        for (unsigned j = 0; j < 16; ++j) { const unsigned c = xb_ld(&bar[XB_XCNT(j)]); sum += c; cnt += (c > 0u) ? 1u : 0u; mine = (j == x) ? c : mine; }
        if (sum == G) break;
        __builtin_amdgcn_s_sleep(1);
        if ((++sp & 255u) == 0u) { if (xb_ld(&bar[XB_TMO])) break; if (sp > XB_SPIN_CAP) { atomicAdd(&bar[XB_TMO], 1u); break; } }
    }
    nloc = mine > 0u ? mine : 1u; nx = cnt > 0u ? cnt : 1u;
}
__device__ __forceinline__ void xcd_barrier(const XcdBarrier& b) {
    asm volatile("s_waitcnt vmcnt(0)" ::: "memory");
    __syncthreads();
    if (threadIdx.x == 0) {
        unsigned* bar = b.bar;
        __builtin_amdgcn_s_waitcnt(0);
        unsigned nloc = b.st[0], nx = b.st[1];
        if (nloc == 0u) { xcd_barrier_complete(bar, b.x, nloc, nx); b.st[0] = nloc; b.st[1] = nx; }
        const unsigned old = xb_add(&bar[XB_XSUB(b.x)], 1u);
        const unsigned gen = old / nloc;
        if (old + 1u == (gen + 1u) * nloc) {
            __builtin_amdgcn_fence(__ATOMIC_RELEASE, "agent");
            asm volatile("s_waitcnt vmcnt(0)" ::: "memory");
            const unsigned og = xb_add(&bar[XB_TOP], 1u);
            const unsigned tg = og / nx;
            if (og + 1u == (tg + 1u) * nx) xb_add(&bar[XB_TOPGEN], 1u);
            else XB_SPIN(xb_ld(&bar[XB_TOPGEN]) == tg, bar);
            __builtin_amdgcn_fence(__ATOMIC_ACQUIRE, "agent");
            xb_add(&bar[XB_XGEN(b.x)], 1u);
            asm volatile("s_waitcnt vmcnt(0)" ::: "memory");
        } else {
            XB_SPIN(xb_ld(&bar[XB_XGEN(b.x)]) == gen, bar);
            __builtin_amdgcn_fence(__ATOMIC_ACQUIRE, "agent");
            asm volatile("s_waitcnt vmcnt(0)" ::: "memory");
        }
    }
    __syncthreads();
}
constexpr int RING_BYTES = 131072, LDSCTL_OFF = RING_BYTES, MISC_OFF = LDSCTL_OFF + 320;
constexpr int LDS_BYTES = 147456;
constexpr int CW_BAR = 4096;

constexpr int N_PHASES = 14;
__device__ __forceinline__ GemmDesc gemm_desc(const Frame& F, int ph) {
    GemmDesc g; float* ST = F.ST; const size_t S1 = (size_t)M * 16;
    g.A = F.XN; g.Bt = F.W_IN; g.N = DM; g.K = DM; g.kind = G_RESID; g.rmode = 0; g.stat = ST; g.nslots = 16; g.inv_dim = 1.0f / DM;
    g.base = nullptr; g.xout = nullptr; g.xn = F.XN; g.stat_out = ST; g.hout = F.H;
    if (ph == 1) { g.Bt = F.W_IN; g.N = N0; g.kind = G_ROWSCALE; g.rmode = R_QKV0; }
    else if (ph == 3) { g.A = F.AO; g.Bt = F.W_OUT; g.base = F.x; g.stat_out = ST + S1; }
    else if (ph == 4) { g.Bt = F.W_GU0; g.N = NGU; g.kind = G_SWIGLU; g.stat = ST + S1; }
    else if (ph == 5) { g.A = F.H; g.Bt = F.W_DN0; g.K = FFH; g.stat_out = ST + 2 * S1; }
    else if (ph == 6) { g.Bt = F.W_MD; g.N = NMD; g.kind = G_ROWSCALE; g.rmode = R_MD; g.stat = ST + 2 * S1; }
    else if (ph == 7) { g.A = F.CQ; g.Bt = F.W_UQ; g.N = NUQ; g.K = QRANK; g.kind = G_ROWSCALE; g.rmode = R_UQ; g.stat = F.SQ; g.nslots = 12; g.inv_dim = 1.0f / QRANK; }
    else if (ph == 8) { g.A = F.CKV; g.Bt = F.W_UKV; g.N = NUKV; g.K = KVRANK; g.kind = G_ROWSCALE; g.rmode = R_UKV; g.stat = F.SKV; g.nslots = 8; g.inv_dim = 1.0f / KVRANK; }
    else if (ph == 10) { g.A = F.AO; g.Bt = F.W_O; g.stat_out = ST + 3 * S1; }
    else if (ph == 11) { g.Bt = F.W_GU1; g.N = NGU; g.kind = G_SWIGLU; g.stat = ST + 3 * S1; }
    else { g.A = F.H; g.Bt = F.W_DN1; g.K = FFH; g.xn = nullptr; g.xout = F.out; g.stat_out = ST + 4 * S1; }
    return g;
}

struct Args { const void* in[18]; float* out; unsigned char* ws; int ph_lo, ph_hi; };
__global__ void __launch_bounds__(NTHR, 2) mk_fwd(Args a) {
    extern __shared__ __attribute__((aligned(16))) unsigned char lds_raw[];
    LAS unsigned char* lds = (LAS unsigned char*)lds_raw;
    Frame F;
    F.tid = threadIdx.x; F.lane = F.tid & 63; F.wave = __builtin_amdgcn_readfirstlane(F.tid >> 6); F.G = gridDim.x; F.bid = blockIdx.x;
    F.x = (const float*)a.in[0]; F.pos = (const int*)a.in[1]; F.attn_norm = (const float*)a.in[2]; F.ffn_norm = (const float*)a.in[3]; F.w_in = (const float*)a.in[4]; F.sinks = (const float*)a.in[5];
    F.w_out = (const float*)a.in[6]; F.relb = (const float*)a.in[7]; F.w_md = (const float*)a.in[8]; F.q_norm = (const float*)a.in[9]; F.w_uq = (const float*)a.in[10]; F.kv_norm = (const float*)a.in[11];
    F.w_ukv = (const float*)a.in[12]; F.w_o = (const float*)a.in[13]; F.w_gate = (const float*)a.in[14]; F.w_up = (const float*)a.in[15]; F.w_down = (const float*)a.in[16]; F.final_norm = (const float*)a.in[17];
    F.out = a.out; F.ws = a.ws; unsigned char* ws = a.ws;
    F.W_IN = (bf16*)(ws + WS_W_IN); F.W_OUT = (bf16*)(ws + WS_W_OUT); F.W_GU0 = (bf16*)(ws + WS_W_GU0); F.W_DN0 = (bf16*)(ws + WS_W_DN0); F.W_MD = (bf16*)(ws + WS_W_MD);
    F.W_UQ = (bf16*)(ws + WS_W_UQ); F.W_UKV = (bf16*)(ws + WS_W_UKV); F.W_O = (bf16*)(ws + WS_W_O); F.W_GU1 = (bf16*)(ws + WS_W_GU1); F.W_DN1 = (bf16*)(ws + WS_W_DN1);
    F.ST = (float*)(ws + WS_ST); F.SQ = (float*)(ws + WS_SQ); F.SKV = (float*)(ws + WS_SKV); F.CS = (f32x2*)(ws + WS_CS);
    F.XN = (bf16*)(ws + WS_XN); F.AO = (bf16*)(ws + WS_AO); F.QKV0 = (bf16*)(ws + WS_QKV0); F.H = (bf16*)(ws + WS_H); F.CQ = (bf16*)(ws + WS_CQ); F.CKV = (bf16*)(ws + WS_CKV);
    F.KR = (bf16*)(ws + WS_KR); F.QN = (bf16*)(ws + WS_QN); F.QR = (bf16*)(ws + WS_QR); F.KN = (bf16*)(ws + WS_KN); F.VV = (bf16*)(ws + WS_VV);

    for (int u = F.tid; u < (LDS_BYTES - LDSCTL_OFF) / 4; u += NTHR) ((LAS unsigned*)(lds + LDSCTL_OFF))[u] = 0u;
    __syncthreads();
    XcdBarrier bar; bar.bar = (unsigned*)(ws + WS_CTL) + CW_BAR; bar.x = 0; bar.st = nullptr;
    if (a.ph_hi - a.ph_lo > 1) bar = xcd_barrier_post((unsigned*)(ws + WS_CTL) + CW_BAR, (volatile LAS unsigned*)(lds + MISC_OFF) + 8);
    for (int ph = a.ph_lo; ph < a.ph_hi; ++ph) {
#if PROBE_MASK
      for (int rep = 0; rep <= ((PROBE_MASK >> ph) & 1); ++rep) {
        if (rep) xcd_barrier(bar);
#endif
        { int t_; asm volatile("v_mov_b32 %0, %1" : "=v"(t_) : "v"(threadIdx.x)); F.tid = t_; F.lane = t_ & 63; }
        if (ph == 0) p0_prologue(F, lds);
        else if (ph == 2) {
#if !USE_FAST_SB
            naive_sb(F);
#endif
#if !USE_FAST_SWA
            naive_swa(F);
#endif
#if USE_FAST_SB || USE_FAST_SWA
            att::attn0_phase(F, lds);
#endif
        }
        else if (ph == 9) {
#if USE_FAST_MLA
            att::attn1_phase(F, lds);
#else
            naive_mla(F);
#endif
        }
        else if (ph == 13) final_norm_phase(F);
        else {
            const GemmDesc g = gemm_desc(F, ph);
#if USE_FAST_GEMM
            const pg8::Gemm pg{g.A, g.Bt, M, g.N, g.K}; pg8::StaticOrder S; S.init(M, g.N, F.G, F.bid);
            if (g.kind == G_ROWSCALE) { const pg8::EpiRowScale E{&F, g.rmode, g.stat, g.nslots, g.inv_dim}; pg8::gemm_phase<pg8::EpiRowScale, pg8::StaticOrder, true, true>(lds, pg, S, E); }
            else if (g.kind == G_SWIGLU) { const pg8::EpiSwiGLU E{g.hout, g.stat, g.nslots, g.inv_dim}; pg8::gemm_phase<pg8::EpiSwiGLU, pg8::StaticOrder, true, true>(lds, pg, S, E); }
            else { const pg8::EpiResid E{g.base, g.xout, g.xn, F.XN, g.stat_out}; pg8::gemm_phase<pg8::EpiResid, pg8::StaticOrder, true, true>(lds, pg, S, E); }
#else
            naive_gemm_phase(F, g);
#endif
        }
#if PROBE_MASK
      }
#endif
        if (ph + 1 < a.ph_hi && ph != 7) xcd_barrier(bar);
    }
}

extern "C" void kernel_launch(void* const* d_in, const int* in_sizes, int n_in, void* d_out, int out_size, void* d_ws, size_t ws_size, hipStream_t stream) {
    static int grid = 0;
    if (grid == 0) {
        if (n_in != 18 || in_sizes[0] != M * DM || out_size != M * DM || ws_size < WS_END) { fprintf(stderr, "kernel_launch: unexpected problem shape / workspace (n_in %d, ws %zu)\n", n_in, ws_size); grid = -1; return; }
        int dev = 0, cus = 0;
        if (hipGetDevice(&dev) != hipSuccess || hipDeviceGetAttribute(&cus, hipDeviceAttributeMultiprocessorCount, dev) != hipSuccess) { grid = -1; return; }
        if (hipFuncSetAttribute((const void*)mk_fwd, hipFuncAttributeMaxDynamicSharedMemorySize, LDS_BYTES) != hipSuccess) { fprintf(stderr, "kernel_launch: hipFuncSetAttribute failed\n"); grid = -1; return; }
        grid = cus;
    }
    if (grid < 0) return;
    Args a{};
    for (int i = 0; i < 18; ++i) a.in[i] = d_in[i];
    a.out = (float*)d_out; a.ws = (unsigned char*)d_ws;
#if MK_ONE_LAUNCH
    if (hipMemsetAsync((char*)d_ws + WS_CTL, 0, 65536, stream) != hipSuccess) { fprintf(stderr, "kernel_launch: memset failed\n"); return; }
    a.ph_lo = 0; a.ph_hi = N_PHASES;
    void* kargs[] = {&a};
    const hipError_t e = hipLaunchCooperativeKernel((const void*)mk_fwd, dim3(grid), dim3(NTHR), kargs, LDS_BYTES, stream);
    if (e != hipSuccess) fprintf(stderr, "kernel_launch: cooperative launch failed: %s (grid %d)\n", hipGetErrorString(e), grid);
#else
    for (int ph = 0; ph < N_PHASES; ++ph) {
        a.ph_lo = ph; a.ph_hi = ph + 1;
        hipLaunchKernelGGL(mk_fwd, dim3(grid), dim3(NTHR), LDS_BYTES, stream, a);
    }
#endif
}
```
